# Optimizing an MI355X kernel written in HIP

```python
import math
import jax, jax.numpy as jnp
from jax import lax
import numpy as np

D_MODEL = 1024
BATCH = 4
SEQ = 8192
DEPTH = 1

GLA_HEADS = 4
GLA_DV = D_MODEL // GLA_HEADS
GLA_DK = GLA_DV // 2
GLA_RANK = 16
GLA_TAU = 16.0
GLA_CHUNK = 64
SWA_HD = 64
SWA_HEADS = D_MODEL // SWA_HD
SWA_KV_HEADS = 2
SWA_WINDOW = 128
ROPE_DIM = SWA_HD // 4
ROPE_THETA = 500000.0
D_FF = 2816
CONV_W = 3
N_BRANCH = 2
LN_EPS = 1e-5
RMS_EPS = 1e-6
ALPHA = (2.0 * DEPTH) ** 0.25
BETA = (8.0 * DEPTH) ** -0.25
N_MOD = 6

SPLITS = (
    GLA_HEADS * GLA_DK,
    GLA_HEADS * GLA_DK,
    GLA_HEADS * GLA_DV,
    GLA_HEADS * GLA_DV,
    GLA_RANK,
    SWA_HEADS * SWA_HD,
    SWA_KV_HEADS * SWA_HD,
    SWA_KV_HEADS * SWA_HD,
    N_BRANCH * D_MODEL,
)
D_IN = sum(SPLITS)
SPLIT_POINTS = tuple(int(v) for v in np.cumsum(SPLITS)[:-1])

kernel_name = "hybrid_gla_swa_convffn_deepnorm_adaln"


def layer_norm(x, eps=LN_EPS):
    xf = x.astype(jnp.float32)
    mu = jnp.mean(xf, -1, keepdims=True)
    var = jnp.mean(jnp.square(xf - mu), -1, keepdims=True)
    return ((xf - mu) * lax.rsqrt(var + eps)).astype(x.dtype)


def layer_norm_affine(x, g, b):
    return layer_norm(x) * g + b


def rms_norm(x, g, eps=RMS_EPS):
    xf = x.astype(jnp.float32)
    y = xf * lax.rsqrt(jnp.mean(jnp.square(xf), -1, keepdims=True) + eps)
    return y.astype(x.dtype) * g


def partial_rope(t, cos, sin):
    half = ROPE_DIM // 2
    t1, t2, rest = t[..., :half], t[..., half:ROPE_DIM], t[..., ROPE_DIM:]
    return jnp.concatenate([t1 * cos - t2 * sin, t2 * cos + t1 * sin, rest], axis=-1)


def gla_chunked(q, k, v, log_a):
    B, S, H, DK = q.shape
    DV = v.shape[-1]
    n = S // GLA_CHUNK

    def to_chunks(t):
        return t.reshape(B, n, GLA_CHUNK, H, t.shape[-1]).transpose(1, 0, 3, 2, 4)

    qc, kc, vc, gc = map(to_chunks, (q, k, v, log_a))
    gcum = jnp.cumsum(gc.astype(jnp.float32), axis=3)
    g_last = gcum[..., -1:, :]
    g_mid = gcum[..., GLA_CHUNK // 2 - 1:GLA_CHUNK // 2, :]
    q_mid = qc * jnp.exp(gcum - g_mid)
    k_mid = kc * jnp.exp(g_mid - gcum)
    a_intra = jnp.einsum('nbhik,nbhjk->nbhij', q_mid, k_mid)
    causal = jnp.tril(jnp.ones((GLA_CHUNK, GLA_CHUNK), dtype=bool))
    a_intra = jnp.where(causal, a_intra, 0.0)
    o_intra = jnp.einsum('nbhij,nbhjv->nbhiv', a_intra, vc.astype(jnp.float32))
    q_in = qc * jnp.exp(gcum)
    k_out = kc * jnp.exp(g_last - gcum)
    decay = jnp.exp(g_last)

    def step(state, inp):
        q_i, k_o, v_i, dec = inp
        o = jnp.einsum('bhik,bhkv->bhiv', q_i, state)
        state = state * dec[:, :, 0, :, None] + jnp.einsum('bhjk,bhjv->bhkv', k_o, v_i.astype(jnp.float32))
        return state, o

    state0 = jnp.zeros((B, H, DK, DV), jnp.float32)
    _, o_inter = lax.scan(step, state0, (q_in, k_out, vc, decay))
    o = (o_intra + o_inter).astype(v.dtype)
    return o.transpose(1, 0, 3, 2, 4).reshape(B, S, H, DV)


def swa_with_sinks(q, k, v, sinks):
    B, S, HQ, hd = q.shape
    HKV = k.shape[2]
    G = HQ // HKV
    W = SWA_WINDOW
    n = S // W
    qb = q.reshape(B, n, W, HKV, G, hd)

    def band(t):
        tb = t.reshape(B, n, W, HKV, hd)
        prev = jnp.pad(tb[:, :-1], ((0, 0), (1, 0), (0, 0), (0, 0), (0, 0)))
        return jnp.concatenate([prev, tb], axis=2)

    kb, vb = band(k), band(v)
    s = jnp.einsum('bnqkgd,bnjkd->bkgnqj', qb, kb).astype(jnp.float32) * (hd ** -0.5)
    qi = jnp.arange(W)[:, None]
    kj = jnp.arange(2 * W)[None, :]
    diff = W + qi - kj
    win = (diff >= 0) & (diff < W)
    blk = jnp.arange(n)[:, None, None]
    mask = win[None] & ((blk > 0) | (kj >= W)[None])
    s = jnp.where(mask[None, None, None], s, -jnp.inf)
    sink = sinks.astype(jnp.float32).reshape(HKV, G)[None, :, :, None, None, None]
    m = jnp.maximum(jnp.max(s, -1, keepdims=True), sink)
    p = jnp.exp(s - m)
    p = p / (jnp.sum(p, -1, keepdims=True) + jnp.exp(sink - m))
    o = jnp.einsum('bkgnqj,bnjkd->bnqkgd', p.astype(v.dtype), vb)
    return o.reshape(B, S, HQ, hd)


def setup_inputs(seed: int = 0) -> dict:
    key = jax.random.key(seed)
    ks = jax.random.split(key, 20)
    f32 = jnp.float32
    L, D = DEPTH, D_MODEL
    nrm = lambda k, shape, s: jax.random.normal(k, shape, f32) * s
    return {
        "x": nrm(ks[0], (BATCH, SEQ, D), 1.0),
        "c": nrm(ks[1], (BATCH, D), 1.0),
        "positions": jnp.broadcast_to(jnp.arange(SEQ, dtype=jnp.int32), (BATCH, SEQ)),
        "w_ada": nrm(ks[2], (L, D, N_MOD * D), 0.5 * D ** -0.5),
        "b_ada": nrm(ks[3], (L, N_MOD * D), 0.01),
        "w_in": nrm(ks[4], (L, D, D_IN), D ** -0.5),
        "gla_w_lr": nrm(ks[5], (L, GLA_RANK, GLA_HEADS * GLA_DK), GLA_RANK ** -0.5),
        "gla_b_lr": nrm(ks[6], (L, GLA_HEADS * GLA_DK), 0.01),
        "gla_norm_g": 1.0 + nrm(ks[7], (L, GLA_DV), 0.01),
        "swa_sinks": nrm(ks[8], (L, SWA_HEADS), 1.0),
        "w_o": nrm(ks[9], (L, D, D), BETA * D ** -0.5),
        "ln1_g": 1.0 + nrm(ks[10], (L, D), 0.01),
        "ln1_b": nrm(ks[11], (L, D), 0.01),
        "w_up": nrm(ks[12], (L, D, 2 * D_FF), D ** -0.5),
        "conv_w": nrm(ks[13], (L, CONV_W, 2 * D_FF), CONV_W ** -0.5),
        "conv_b": nrm(ks[14], (L, 2 * D_FF), 0.01),
        "w_down": nrm(ks[15], (L, D_FF, D), BETA * D_FF ** -0.5),
        "ln2_g": 1.0 + nrm(ks[16], (L, D), 0.01),
        "ln2_b": nrm(ks[17], (L, D), 0.01),
    }


def reference(x, c, positions, w_ada, b_ada, w_in, gla_w_lr, gla_b_lr, gla_norm_g, swa_sinks,
              w_o, ln1_g, ln1_b, w_up, conv_w, conv_b, w_down, ln2_g, ln2_b):
    B, S, D = x.shape
    inv_freq = ROPE_THETA ** (-(jnp.arange(0, ROPE_DIM, 2, dtype=jnp.float32) / ROPE_DIM))
    ang = positions.astype(jnp.float32)[..., None] * inv_freq
    cos = jnp.cos(ang)[:, :, None, :].astype(x.dtype)
    sin = jnp.sin(ang)[:, :, None, :].astype(x.dtype)
    c_act = jax.nn.silu(c)

    for l in range(DEPTH):
        mod = c_act @ w_ada[l] + b_ada[l]
        shift1, scale1, gate1, shift2, scale2, gate2 = [m[:, None, :] for m in jnp.split(mod, N_MOD, axis=-1)]

        h = layer_norm(x) * (1.0 + scale1) + shift1
        proj = h @ w_in[l]
        qa, ka, va, ra, lra, qb, kb, vb, gates = jnp.split(proj, SPLIT_POINTS, axis=-1)

        log_a = jax.nn.log_sigmoid((lra @ gla_w_lr[l] + gla_b_lr[l]).astype(jnp.float32)) / GLA_TAU
        qa = qa.reshape(B, S, GLA_HEADS, GLA_DK) * (GLA_DK ** -0.5)
        ka = ka.reshape(B, S, GLA_HEADS, GLA_DK)
        va = va.reshape(B, S, GLA_HEADS, GLA_DV)
        log_a = log_a.reshape(B, S, GLA_HEADS, GLA_DK)
        o_a = gla_chunked(qa, ka, va, log_a)
        y_a = (rms_norm(o_a, gla_norm_g[l]) * jax.nn.silu(ra.reshape(B, S, GLA_HEADS, GLA_DV))).reshape(B, S, D)

        qb = partial_rope(qb.reshape(B, S, SWA_HEADS, SWA_HD), cos, sin)
        kb = partial_rope(kb.reshape(B, S, SWA_KV_HEADS, SWA_HD), cos, sin)
        vb = vb.reshape(B, S, SWA_KV_HEADS, SWA_HD)
        y_b = swa_with_sinks(qb, kb, vb, swa_sinks[l]).reshape(B, S, D)

        g_a, g_b = jnp.split(gates, N_BRANCH, axis=-1)
        y = jax.nn.sigmoid(g_a) * y_a + jax.nn.sigmoid(g_b) * y_b
        x = layer_norm_affine(ALPHA * x + gate1 * (y @ w_o[l]), ln1_g[l], ln1_b[l])

        h2 = layer_norm(x) * (1.0 + scale2) + shift2
        u = h2 @ w_up[l]
        up = jnp.pad(u, ((0, 0), (CONV_W - 1, 0), (0, 0)))
        u = conv_b[l] + sum(conv_w[l, t] * up[:, t:t + S] for t in range(CONV_W))
        u_gate, u_val = jnp.split(u, 2, axis=-1)
        f = jax.nn.gelu(u_gate, approximate=False) * u_val
        x = layer_norm_affine(ALPHA * x + gate2 * (f @ w_down[l]), ln2_g[l], ln2_b[l])

    return x
```

```cpp
#include <hip/hip_runtime.h>
#include <hip/hip_cooperative_groups.h>
#include <cstdio>
namespace cg = cooperative_groups;

#define LAS __attribute__((address_space(3)))
typedef unsigned short bf16_t;
typedef short bf16x8 __attribute__((ext_vector_type(8)));
typedef short bf16x4 __attribute__((ext_vector_type(4)));
typedef float f32x4 __attribute__((ext_vector_type(4)));
typedef float f32x2 __attribute__((ext_vector_type(2)));
typedef float f32x16 __attribute__((ext_vector_type(16)));
typedef unsigned u32x4 __attribute__((ext_vector_type(4)));
typedef unsigned u32x2 __attribute__((ext_vector_type(2)));
typedef _Float16 f16x4 __attribute__((ext_vector_type(4)));

constexpr int T_TOK = 32768, DM = 1024, SEQ = 8192, NPJ = 5760  , DFF = 2816;
constexpr int HB = 1024, H_Q = 0, H_K = 128, H_V = 256, H_WA = 512, H_GB = 768, C_QB = 4096, C_KB = 5120, C_VB = 5248, C_LR = 5376;
constexpr float ALPHA = 1.189207115002721f, LOG2E = 1.4426950408889634f;
constexpr int NWG = 256, NTH = 512;
constexpr int LDS_CW = 131072 + 512;
constexpr int LDS_BYTES = 155648;
constexpr size_t OFF_WIN = 0, OFF_WO = 13631488, OFF_WUP = 15728640, OFF_WDN = 27262976, OFF_MODP = 33030144, OFF_MODF = 34603008,
                 OFF_ROPE = 34701312, OFF_DEC = 36798464, OFF_DSUP = 37847040, OFF_BAR = 37978112, OFF_PROJ = 38797312;
constexpr size_t PROJ_BYTES = (size_t)T_TOK * NPJ * 2;
constexpr size_t OFF_H2 = OFF_PROJ + (1u << 20), OFF_F = OFF_PROJ + (80u << 20), OFF_X1 = OFF_PROJ + (256u << 20), OFF_ACC1 = OFF_PROJ + (363u << 20), OFF_HT = OFF_PROJ + (428u << 20);
constexpr size_t WS_NEED = OFF_PROJ + (451u << 20);
constexpr size_t OO_H = 0, OO_KOT = 0, OO_ABUF = (32u << 20), OO_USUP = (48u << 20), OO_ACC1 = 0;

struct Params {
    const float* x; const float* c; const int* pos; const float* w_ada; const float* b_ada; const float* w_in; const float* w_lr; const float* b_lr;
    const float* gnorm; const float* sinks; const float* w_o; const float* ln1g; const float* ln1b; const float* w_up; const float* conv_w; const float* conv_b;
    const float* w_down; const float* ln2g; const float* ln2b; float* out; unsigned char* ws;
};

__device__ __forceinline__ float bf2f(bf16_t b) { return __uint_as_float(((unsigned)b) << 16); }
__device__ __forceinline__ unsigned cvt_pk(float lo, float hi) { unsigned r; asm("v_cvt_pk_bf16_f32 %0, %1, %2" : "=v"(r) : "v"(lo), "v"(hi)); return r; }
__device__ __forceinline__ bf16_t f2bf(float f) { return (bf16_t)(cvt_pk(f, 0.f) & 0xFFFFu); }
__device__ __forceinline__ f32x4 bf4_to_f32(u32x2 v) { f32x4 r; r[0] = __uint_as_float(v[0] << 16); r[1] = __uint_as_float(v[0] & 0xFFFF0000u); r[2] = __uint_as_float(v[1] << 16); r[3] = __uint_as_float(v[1] & 0xFFFF0000u); return r; }
__device__ __forceinline__ float wave_sum(float v) {
#pragma unroll
    for (int o = 32; o; o >>= 1) v += __shfl_xor(v, o);
    return v; }
__device__ __forceinline__ int tid_opaque() { int t = threadIdx.x; asm volatile("" : "+v"(t)); return t; }
__device__ __forceinline__ float sigmoidf_(float v) { return __builtin_amdgcn_rcpf(1.f + __expf(-v)); }
__device__ __forceinline__ void lds_barrier() { asm volatile("s_waitcnt lgkmcnt(0)\n\ts_barrier" ::: "memory"); }


#define XB_TMO      128
#define XB_XCNT(j)  (256  + 64 * (j))
#define XB_XSUB(j)  (1280 + 64 * (j))
#define XB_XGEN(j)  (2304 + 64 * (j))
#define XB_TOP      3328
#define XB_TOPGEN   3392
#define XCD_BAR_WORDS 3456
#define XB_SPIN_CAP (1u << 22)
__device__ __forceinline__ unsigned xb_ld(unsigned* p)              { return __hip_atomic_load(p, __ATOMIC_RELAXED, __HIP_MEMORY_SCOPE_AGENT); }
__device__ __forceinline__ unsigned xb_add(unsigned* p, unsigned v) { return __hip_atomic_fetch_add(p, v, __ATOMIC_RELAXED, __HIP_MEMORY_SCOPE_AGENT); }
__device__ __forceinline__ unsigned xb_xcc_id() { return (unsigned)__builtin_amdgcn_s_getreg((3 << 11) | 20) & 0xFu; }
#define XB_SPIN(cond, bar) do { unsigned _sp = 0; while (cond) {   \
    if ((++_sp & 255u) == 0u) { if (xb_ld(&(bar)[XB_TMO])) break; if (_sp > XB_SPIN_CAP) { atomicAdd(&(bar)[XB_TMO], 1u); break; } } } } while (0)
struct XcdBarrier { unsigned* bar; unsigned x; volatile LAS unsigned* st; };
__device__ __forceinline__ XcdBarrier xcd_barrier_post(unsigned* bar, volatile LAS unsigned* st) {
    XcdBarrier b; b.bar = bar; b.x = xb_xcc_id(); b.st = st;
    if (threadIdx.x == 0) (void)xb_add(&bar[XB_XCNT(b.x)], 1u);
    return b;
}
__device__ __forceinline__ void xcd_barrier_complete(unsigned* bar, unsigned x, unsigned& nloc, unsigned& nx) {
    const unsigned G = gridDim.x * gridDim.y * gridDim.z;
    unsigned sum, cnt, mine, sp = 0u;
    for (;;) {
        sum = 0u; cnt = 0u; mine = 0u;
#pragma unroll
        for (unsigned j = 0; j < 16; ++j) { const unsigned c = xb_ld(&bar[XB_XCNT(j)]); sum += c; cnt += (c > 0u) ? 1u : 0u; mine = (j == x) ? c : mine; }
        if (sum == G) break;
        __builtin_amdgcn_s_sleep(1);
        if ((++sp & 255u) == 0u) { if (xb_ld(&bar[XB_TMO])) break; if (sp > XB_SPIN_CAP) { atomicAdd(&bar[XB_TMO], 1u); break; } }
    }
    nloc = mine > 0u ? mine : 1u; nx = cnt > 0u ? cnt : 1u;
}
__device__ __forceinline__ void xcd_barrier(const XcdBarrier& b) {
    asm volatile("s_waitcnt vmcnt(0)" ::: "memory");
    __syncthreads();
    if (threadIdx.x == 0) {
        unsigned* bar = b.bar;
        __builtin_amdgcn_s_waitcnt(0);
        unsigned nloc = b.st[0], nx = b.st[1];
        if (nloc == 0u) { xcd_barrier_complete(bar, b.x, nloc, nx); b.st[0] = nloc; b.st[1] = nx; }
        const unsigned old = xb_add(&bar[XB_XSUB(b.x)], 1u);
        const unsigned gen = old / nloc;
        if (old + 1u == (gen + 1u) * nloc) {
            __builtin_amdgcn_fence(__ATOMIC_RELEASE, "agent");
            asm volatile("s_waitcnt vmcnt(0)" ::: "memory");
            const unsigned og = xb_add(&bar[XB_TOP], 1u);
            const unsigned tg = og / nx;
            if (og + 1u == (tg + 1u) * nx) xb_add(&bar[XB_TOPGEN], 1u);
            else XB_SPIN(xb_ld(&bar[XB_TOPGEN]) == tg, bar);
            __builtin_amdgcn_fence(__ATOMIC_ACQUIRE, "agent");
            xb_add(&bar[XB_XGEN(b.x)], 1u);
            asm volatile("s_waitcnt vmcnt(0)" ::: "memory");
        } else {
            XB_SPIN(xb_ld(&bar[XB_XGEN(b.x)]) == gen, bar);
            __builtin_amdgcn_fence(__ATOMIC_ACQUIRE, "agent");
            asm volatile("s_waitcnt vmcnt(0)" ::: "memory");
        }
    }
    __syncthreads();
}

namespace pg8 {
constexpr int BM = 256, BK = 64, HALF = 128, HTB = HALF * BK * 2, NXCD = 8, WGM = 8;
__device__ __forceinline__ int lds_byte(int r, int c) { const int st = (r >> 4) * 2 + (c >> 5), rr = r & 15, cc = c & 31, ob = rr * 64 + cc * 2; return st * 1024 + (ob ^ (((ob >> 9) & 1) << 5)); }
__device__ __forceinline__ void stage_rc(int b, int& R, int& C) { const int st = b / 1024, sb = b % 1024, swz = sb ^ (((sb >> 9) & 1) << 5); R = (st >> 1) * 16 + swz / 64; C = (st & 1) * 32 + (swz % 64) / 2; }
__device__ __forceinline__ int perm32(int rho) { const int n = rho >> 4, i = rho & 15; return 8 * (i >> 2) + 4 * n + (i & 3); }
struct Unit { int pm, pn; };
struct Gemm { const bf16_t* A; const bf16_t* Bt; int nM, nN, K, lda, grp; };
struct StaticOrder {
    int nM, nN, nwg, G, c;
    __device__ void init(int nM_, int nN_, int G_, int c_) { nM = nM_; nN = nN_; nwg = nM * nN; G = G_; c = c_; }
    __device__ bool next(int i, Unit& u) const {
        const long L = (long)i * G + c; if (L >= nwg) return false;
        int wgid = (int)L; { const int q = nwg / NXCD, r = nwg % NXCD, xcd = wgid % NXCD, off = wgid / NXCD; wgid = (xcd < r ? xcd * (q + 1) : r * (q + 1) + (xcd - r) * q) + off; }
        const int nig = WGM * nN, gid = wgid / nig, fm = gid * WGM, gsz = (nM - fm) < WGM ? (nM - fm) : WGM;
        u.pm = fm + ((wgid % nig) % gsz); u.pn = (wgid % nig) / gsz; return true;
    }
};

#ifndef PG8_SP2
#define PG8_SP2 true
#endif
#ifndef PG8_ALIGN
#define PG8_ALIGN true
#endif
template <class Epi, bool ALIGN_EPI = PG8_ALIGN, bool SP2 = PG8_SP2>
__device__ __forceinline__ void gemm_phase(LAS unsigned char* lds, const Gemm g, const StaticOrder& S, const Epi& E) {
    int tid = threadIdx.x; asm volatile("" : "+v"(tid));
    const int wid = __builtin_amdgcn_readfirstlane(tid >> 6), lane = tid & 63, wr = wid >> 2, wc = wid & 3, fr = lane & 15, fq = lane >> 4;
    const int K = g.K, nt = K / BK;
    unsigned voffA[2], voffB[2];
#pragma unroll
    for (int i = 0; i < 2; ++i) { int R, C; stage_rc(tid * 16 + i * 8192, R, C); const int Rb = Epi::PERM ? ((R & ~31) + perm32(R & 31)) : R;
        voffA[i] = (unsigned)(((R >> 6) * g.grp + (R & 63)) * g.lda + C) * 2u; voffB[i] = (unsigned)(Rb * K + C) * 2u; }
    const size_t kstep = (size_t)(BK * 2);
    const size_t hstepA = (size_t)2 * g.grp * g.lda * 2, tstepA = 2 * hstepA;
    const size_t hstepB = (size_t)HALF * K * 2, tstepB = 2 * hstepB;
    const unsigned ldsw = (unsigned)wid * 1024u;
    const int aoff = lds_byte(wr * 64 + fr, fq * 8), boff = lds_byte(wc * 32 + fr, fq * 8);
#define PG8_SA(b, h) (((b) * 2 + (h)) * HTB)
#define PG8_SB(b, h) ((4 + (b) * 2 + (h)) * HTB)
#define PG8_STAGE(bufoff, gbase, voff) do { _Pragma("unroll") for (int _i = 0; _i < 2; ++_i) \
        __builtin_amdgcn_global_load_lds((const unsigned*)((const char*)(gbase) + (voff)[_i]), (LAS unsigned*)(lds + (bufoff) + ldsw + _i * 8192), 16, 0, 0); } while (0)
#define PG8_LDA(dst, b, h) do { _Pragma("unroll") for (int m = 0; m < 4; ++m) _Pragma("unroll") for (int k = 0; k < 2; ++k) dst[m][k] = *(const LAS bf16x8*)(lds + PG8_SA(b, h) + aoff + m * 2048 + k * 1024); } while (0)
#define PG8_LDB(dst, b, h) do { _Pragma("unroll") for (int n = 0; n < 2; ++n) _Pragma("unroll") for (int k = 0; k < 2; ++k) dst[n][k] = *(const LAS bf16x8*)(lds + PG8_SB(b, h) + boff + n * 2048 + k * 1024); } while (0)
#define PG8_MMA(ai, bj, At, Bt) do { __builtin_amdgcn_s_setprio(1); _Pragma("unroll") for (int m = 0; m < 4; ++m) _Pragma("unroll") for (int n = 0; n < 2; ++n) _Pragma("unroll") for (int k = 0; k < 2; ++k) \
        acc[ai][bj][m][n] = __builtin_amdgcn_mfma_f32_16x16x32_bf16(Bt[n][k], At[m][k], acc[ai][bj][m][n], 0, 0, 0); __builtin_amdgcn_s_setprio(0); } while (0)
#define PG8_WAIT_V(n) asm volatile("s_waitcnt vmcnt(" #n ")" ::: "memory")
#define PG8_WAIT_L(n) asm volatile("s_waitcnt lgkmcnt(" #n ")" ::: "memory")
#define PG8_BAR __builtin_amdgcn_s_barrier()
#define PG8_SCHED __builtin_amdgcn_sched_barrier(0)
    Unit cur, nxt; int ui = 0;
    if (!S.next(0, cur)) return;
    E.prefetch(cur, lds, 0, wid, lane);
    f32x4 acc[2][2][4][2];
#pragma unroll
    for (int a = 0; a < 2; ++a)
#pragma unroll
        for (int b = 0; b < 2; ++b)
#pragma unroll
            for (int m = 0; m < 4; ++m)
#pragma unroll
                for (int n = 0; n < 2; ++n) acc[a][b][m][n] = (f32x4){0.f, 0.f, 0.f, 0.f};
    bf16x8 At[4][2], B0[2][2], B1[2][2];
    const char* cA = (const char*)g.A + (size_t)cur.pm * tstepA; const char* cB = (const char*)g.Bt + (size_t)cur.pn * tstepB;
    if constexpr (SP2) {
        PG8_STAGE(PG8_SB(0, 0), cB, voffB); PG8_STAGE(PG8_SB(0, 1), cB + hstepB, voffB); PG8_STAGE(PG8_SA(0, 0), cA, voffA); PG8_STAGE(PG8_SA(0, 1), cA + hstepA, voffA);
        if (wr == 1) PG8_BAR;
        PG8_WAIT_V(2); PG8_BAR;
        PG8_STAGE(PG8_SB(1, 0), cB + kstep, voffB); PG8_STAGE(PG8_SA(1, 0), cA + kstep, voffA); PG8_STAGE(PG8_SB(1, 1), cB + hstepB + kstep, voffB);
        PG8_WAIT_V(6); PG8_BAR;
    } else {
        PG8_STAGE(PG8_SB(0, 0), cB, voffB); PG8_STAGE(PG8_SA(0, 0), cA, voffA); PG8_STAGE(PG8_SB(0, 1), cB + hstepB, voffB); PG8_STAGE(PG8_SA(0, 1), cA + hstepA, voffA);
        if (wr == 1) PG8_BAR;
        PG8_WAIT_V(4); PG8_BAR;
        PG8_STAGE(PG8_SB(1, 0), cB + kstep, voffB); PG8_STAGE(PG8_SA(1, 0), cA + kstep, voffA); PG8_STAGE(PG8_SB(1, 1), cB + hstepB + kstep, voffB);
        PG8_WAIT_V(6); PG8_BAR;
    }
    for (;;) {
        const bool has_next = S.next(ui + 1, nxt);
        const char* nA = has_next ? (const char*)g.A + (size_t)nxt.pm * tstepA : cA; const char* nB = has_next ? (const char*)g.Bt + (size_t)nxt.pn * tstepB : cB;
        for (int t = 0; t < nt; t += 2) {
            const bool last = (t == nt - 2);
            const char* a1 = cA + (size_t)(t + 1) * kstep;
            const char* a2 = last ? nA : cA + (size_t)(t + 2) * kstep; const char* b2 = last ? nB : cB + (size_t)(t + 2) * kstep;
            const char* a3 = a2 + kstep; const char* b3 = b2 + kstep;
            if constexpr (SP2) {
            PG8_LDB(B0, 0, 0); PG8_LDB(B1, 0, 1); PG8_SCHED; PG8_LDA(At, 0, 0); PG8_STAGE(PG8_SA(1, 1), a1 + hstepA, voffA);
            PG8_WAIT_V(8); PG8_WAIT_L(0); PG8_BAR; PG8_MMA(0, 0, At, B0); PG8_MMA(0, 1, At, B1); PG8_BAR; PG8_SCHED;
            PG8_LDA(At, 0, 1); PG8_STAGE(PG8_SB(0, 0), b2, voffB); PG8_STAGE(PG8_SB(0, 1), b2 + hstepB, voffB); PG8_STAGE(PG8_SA(0, 0), a2, voffA);
            PG8_WAIT_V(8); PG8_WAIT_L(0); PG8_BAR; PG8_MMA(1, 0, At, B0); PG8_MMA(1, 1, At, B1); PG8_BAR; PG8_SCHED;
            PG8_LDB(B0, 1, 0); PG8_LDB(B1, 1, 1); PG8_SCHED; PG8_LDA(At, 1, 0); PG8_STAGE(PG8_SA(0, 1), a2 + hstepA, voffA);
            PG8_WAIT_V(8); PG8_WAIT_L(0); PG8_BAR; PG8_MMA(0, 0, At, B0); PG8_MMA(0, 1, At, B1); PG8_BAR; PG8_SCHED;
            PG8_LDA(At, 1, 1); PG8_STAGE(PG8_SB(1, 0), b3, voffB); PG8_STAGE(PG8_SB(1, 1), b3 + hstepB, voffB); PG8_STAGE(PG8_SA(1, 0), a3, voffA);
            PG8_WAIT_V(8); PG8_WAIT_L(0); PG8_BAR; PG8_MMA(1, 0, At, B0); PG8_MMA(1, 1, At, B1); PG8_BAR; PG8_SCHED;
            } else {
            PG8_LDB(B0, 0, 0); PG8_SCHED; PG8_LDA(At, 0, 0); PG8_STAGE(PG8_SA(1, 1), a1 + hstepA, voffA);
            PG8_WAIT_L(8); PG8_BAR; PG8_WAIT_L(0); PG8_MMA(0, 0, At, B0); PG8_BAR; PG8_SCHED;
            PG8_LDB(B1, 0, 1); PG8_STAGE(PG8_SB(0, 0), b2, voffB);
            PG8_BAR; PG8_WAIT_L(0); PG8_MMA(0, 1, At, B1); PG8_BAR;
            PG8_LDA(At, 0, 1); PG8_STAGE(PG8_SA(0, 0), a2, voffA);
            PG8_BAR; PG8_WAIT_L(0); PG8_MMA(1, 0, At, B0); PG8_BAR; PG8_SCHED;
            PG8_STAGE(PG8_SB(0, 1), b2 + hstepB, voffB);
            PG8_WAIT_V(6); PG8_BAR; PG8_MMA(1, 1, At, B1); PG8_BAR;
            PG8_LDB(B0, 1, 0); PG8_SCHED; PG8_LDA(At, 1, 0); PG8_STAGE(PG8_SA(0, 1), a2 + hstepA, voffA);
            PG8_WAIT_L(8); PG8_BAR; PG8_WAIT_L(0); PG8_MMA(0, 0, At, B0); PG8_BAR; PG8_SCHED;
            PG8_LDB(B1, 1, 1); PG8_STAGE(PG8_SB(1, 0), b3, voffB);
            PG8_BAR; PG8_WAIT_L(0); PG8_MMA(0, 1, At, B1); PG8_BAR;
            PG8_LDA(At, 1, 1); PG8_STAGE(PG8_SA(1, 0), a3, voffA);
            PG8_BAR; PG8_WAIT_L(0); PG8_MMA(1, 0, At, B0); PG8_BAR; PG8_SCHED;
            PG8_STAGE(PG8_SB(1, 1), b3 + hstepB, voffB);
            PG8_WAIT_V(6); PG8_BAR; PG8_MMA(1, 1, At, B1); PG8_BAR;
            }
        }
        if constexpr (ALIGN_EPI) { if (wr == 0) PG8_BAR; }
        E(acc, cur, wr, wc, fr, fq, lds, ui & 1);
        if (!has_next) break;
#pragma unroll
        for (int a = 0; a < 2; ++a)
#pragma unroll
            for (int b = 0; b < 2; ++b)
#pragma unroll
                for (int m = 0; m < 4; ++m)
#pragma unroll
                    for (int n = 0; n < 2; ++n) acc[a][b][m][n] = (f32x4){0.f, 0.f, 0.f, 0.f};
        cur = nxt; cA = nA; cB = nB; ++ui;
        E.prefetch(cur, lds, ui & 1, wid, lane);
        if constexpr (ALIGN_EPI) { if (wr == 1) PG8_BAR; }
    }
    PG8_WAIT_V(0);
    if constexpr (!ALIGN_EPI) { if (wr == 0) PG8_BAR; }
    PG8_BAR;
#undef PG8_SA
#undef PG8_SB
#undef PG8_STAGE
#undef PG8_LDA
#undef PG8_LDB
#undef PG8_MMA
#undef PG8_WAIT_V
#undef PG8_WAIT_L
#undef PG8_BAR
#undef PG8_SCHED
}
}

__device__ __forceinline__ float gelu_f(float v) {
    const float av = fabsf(v), t = __builtin_amdgcn_rcpf(av * 0.2316418882f + 1.0f);
    float q = t * 0.5307027145f + (-0.7265760135f); q = q * t + 0.7107068705f; q = q * t + (-0.142248368f); q = q * t + 0.127414796f; q = q * t;
    const float e = __builtin_amdgcn_exp2f((v * v) * (-0.72134752044f));
    const float m = v * (q * e);
    return fmaxf(v, 0.f) - fabsf(m);
}

__device__ __forceinline__ f32x2 gelu_pk(f32x2 v) {
    const f32x2 av = __builtin_elementwise_abs(v), d = av * 0.2316418882f + 1.0f;
    f32x2 t; t.x = __builtin_amdgcn_rcpf(d.x); t.y = __builtin_amdgcn_rcpf(d.y);
    f32x2 q = t * 0.5307027145f + (-0.7265760135f); q = q * t + 0.7107068705f; q = q * t + (-0.142248368f); q = q * t + 0.127414796f; q = q * t;
    const f32x2 s = (v * v) * (-0.72134752044f);
    f32x2 e; e.x = __builtin_amdgcn_exp2f(s.x); e.y = __builtin_amdgcn_exp2f(s.y);
    const f32x2 m = v * (q * e);
    f32x2 o; o.x = fmaxf(v.x, 0.f) - fabsf(m.x); o.y = fmaxf(v.y, 0.f) - fabsf(m.y); return o;
}

struct EpiProj {
    static constexpr bool PERM = true;
    bf16_t* O; int ld;
    __device__ __forceinline__ void prefetch(const pg8::Unit&, LAS unsigned char*, int, int, int) const {}
    __device__ __forceinline__ void operator()(const f32x4 (&acc)[2][2][4][2], const pg8::Unit& u, int wr, int wc, int fr, int fq, LAS unsigned char*, int) const {
        const int row0 = u.pm * 256 + wr * 64 + fr, col0 = u.pn * 256 + wc * 32 + 8 * fq;
#pragma unroll
        for (int ai = 0; ai < 2; ++ai)
#pragma unroll
            for (int m = 0; m < 4; ++m) { bf16_t* rowp = O + (size_t)(row0 + ai * 128 + m * 16) * ld + col0;
#pragma unroll
                for (int bj = 0; bj < 2; ++bj) { const f32x4 v0 = acc[ai][bj][m][0], v1 = acc[ai][bj][m][1];
                    u32x4 o; o[0] = cvt_pk(v0[0], v0[1]); o[1] = cvt_pk(v0[2], v0[3]); o[2] = cvt_pk(v1[0], v1[1]); o[3] = cvt_pk(v1[2], v1[3]);
                    *(u32x4*)(rowp + bj * 128) = o; } }
    }
};
struct EpiProjIn {
    static constexpr bool PERM = true;
    bf16_t* O;
    __device__ __forceinline__ void prefetch(const pg8::Unit&, LAS unsigned char*, int, int, int) const {}
    __device__ __forceinline__ void operator()(const f32x4 (&acc)[2][2][4][2], const pg8::Unit& u, int wr, int wc, int fr, int fq, LAS unsigned char*, int) const {
        const int row0 = u.pm * 256 + wr * 64 + fr;
        int cb; bool pair = false;
        if (u.pn < 20) { const int h = u.pn / 5, t = u.pn - 5 * h; pair = (t == 2) || (t == 3); cb = h * HB + ((t == 0) ? 0 : (t == 1) ? H_V : (t == 2) ? H_WA : (t == 3) ? (H_WA + 128) : H_GB); }
        else cb = (u.pn < 24) ? (C_QB + (u.pn - 20) * 256) : (u.pn == 24) ? C_KB : C_LR;
        const int col0 = cb + wc * 32 + 8 * fq;
        if (pair) {
#pragma unroll
            for (int ai = 0; ai < 2; ++ai)
#pragma unroll
                for (int m = 0; m < 4; ++m) { float wv[8];
#pragma unroll
                    for (int j2 = 0; j2 < 4; ++j2) {
                        const f32x2 r = {acc[ai][0][m][j2 >> 1][2 * (j2 & 1)], acc[ai][0][m][j2 >> 1][2 * (j2 & 1) + 1]}, g = {acc[ai][1][m][j2 >> 1][2 * (j2 & 1)], acc[ai][1][m][j2 >> 1][2 * (j2 & 1) + 1]};
                        const f32x2 xr = r * (-LOG2E), xg = g * (-LOG2E);
                        f32x2 er, eg; er.x = __builtin_amdgcn_exp2f(xr.x); er.y = __builtin_amdgcn_exp2f(xr.y); eg.x = __builtin_amdgcn_exp2f(xg.x); eg.y = __builtin_amdgcn_exp2f(xg.y);
                        const f32x2 den = (er + 1.0f) * (eg + 1.0f);
                        f32x2 rc; rc.x = __builtin_amdgcn_rcpf(den.x); rc.y = __builtin_amdgcn_rcpf(den.y);
                        const f32x2 w = r * rc; wv[2 * j2] = w.x; wv[2 * j2 + 1] = w.y; }
                    u32x4 o; o[0] = cvt_pk(wv[0], wv[1]); o[1] = cvt_pk(wv[2], wv[3]); o[2] = cvt_pk(wv[4], wv[5]); o[3] = cvt_pk(wv[6], wv[7]);
                    *(u32x4*)(O + (size_t)(row0 + ai * 128 + m * 16) * NPJ + col0) = o; }
        } else {
            if (u.pn == 25 && (wc != 0 || fq >= 2)) return;
            const int nbj = (u.pn == 25) ? 1 : 2;
#pragma unroll
            for (int ai = 0; ai < 2; ++ai)
#pragma unroll
                for (int m = 0; m < 4; ++m) { bf16_t* rowp = O + (size_t)(row0 + ai * 128 + m * 16) * NPJ + col0;
#pragma unroll
                    for (int bj = 0; bj < 2; ++bj) { if (bj >= nbj) continue; const f32x4 v0 = acc[ai][bj][m][0], v1 = acc[ai][bj][m][1];
                        u32x4 o; o[0] = cvt_pk(v0[0], v0[1]); o[1] = cvt_pk(v0[2], v0[3]); o[2] = cvt_pk(v1[0], v1[1]); o[3] = cvt_pk(v1[2], v1[3]);
                        *(u32x4*)(rowp + bj * 128) = o; } }
        }
    }
};
struct EpiUp {
    static constexpr bool PERM = true;
    bf16_t* F; const float* cw; const float* cb; bf16_t* HT;
    __device__ __forceinline__ void prefetch(const pg8::Unit& u, LAS unsigned char* lds, int par, int wid, int lane) const {
        if (wid < 4) { const int li = wid * 64 + lane, row = li >> 5, ch = u.pn * 128 + (li & 31) * 4;
            const float* src = ((row & 3) == 3) ? (cb + (row >> 2) * DFF + ch) : (cw + (row & 3) * 2 * DFF + (row >> 2) * DFF + ch);
            __builtin_amdgcn_global_load_lds((const unsigned*)src, (LAS unsigned*)(lds + LDS_CW + par * 4096 + wid * 1024), 16, 0, 0); }
    }
    __device__ __forceinline__ void operator()(const f32x4 (&acc)[2][2][4][2], const pg8::Unit& u, int wr, int wc, int fr, int fq, LAS unsigned char* lds, int par) const {
        const int ch0 = u.pn * 128 + wc * 32 + 8 * fq;
        u32x2 pk0[2][4];
#pragma unroll
        for (int n = 0; n < 2; ++n) {
            const LAS float* wl = (const LAS float*)(lds + LDS_CW + par * 4096) + wc * 32 + 8 * fq + 4 * n;
            const f32x4 wg0 = *(const LAS f32x4*)(wl), wg1 = *(const LAS f32x4*)(wl + 128), wg2 = *(const LAS f32x4*)(wl + 256), bg = *(const LAS f32x4*)(wl + 384);
            const f32x4 wv0 = *(const LAS f32x4*)(wl + 512), wv1 = *(const LAS f32x4*)(wl + 640), wv2 = *(const LAS f32x4*)(wl + 768), bv = *(const LAS f32x4*)(wl + 896);
#pragma unroll
            for (int ai = 0; ai < 2; ++ai) {
                const int grp = 4 * u.pm + 2 * ai + wr, tg0 = grp * 64;
#pragma unroll
                for (int m = 0; m < 4; ++m) {
                    const int tk = tg0 + 16 * m + fr;
                    float fo[4];
#pragma unroll
                    for (int e2 = 0; e2 < 2; ++e2) {
                        f32x2 r[2];
#pragma unroll
                        for (int bj = 0; bj < 2; ++bj) {
                            f32x2 cur, p1, p2;
#pragma unroll
                            for (int q = 0; q < 2; ++q) { const int e = 2 * e2 + q; const float c = acc[ai][bj][m][n][e]; cur[q] = c;
                                float t1 = c, t2 = c;
                                if (m > 0) { const float prv = acc[ai][bj][m > 0 ? m - 1 : 0][n][e]; t1 = (fr == 15) ? prv : c; t2 = (fr >= 14) ? prv : c; }
                                const int i1 = __builtin_bit_cast(int, t1), i2 = __builtin_bit_cast(int, t2);
                                p1[q] = __builtin_bit_cast(float, __builtin_amdgcn_update_dpp(i1, i1, 0x121, 0xF, 0xF, true));
                                p2[q] = __builtin_bit_cast(float, __builtin_amdgcn_update_dpp(i2, i2, 0x122, 0xF, 0xF, true)); }
                            const f32x4 W0 = bj ? wv0 : wg0, W1 = bj ? wv1 : wg1, W2 = bj ? wv2 : wg2, BB = bj ? bv : bg;
                            const f32x2 w0 = {W0[2 * e2], W0[2 * e2 + 1]}, w1 = {W1[2 * e2], W1[2 * e2 + 1]}, w2 = {W2[2 * e2], W2[2 * e2 + 1]}, bb = {BB[2 * e2], BB[2 * e2 + 1]};
                            r[bj] = bb + w0 * p2 + w1 * p1 + w2 * cur;
                        }
                        { const f32x2 ff = gelu_pk(r[0]) * r[1]; fo[2 * e2] = ff[0]; fo[2 * e2 + 1] = ff[1]; }
                    }
                    u32x2 o; o[0] = cvt_pk(fo[0], fo[1]); o[1] = cvt_pk(fo[2], fo[3]);
                    if (n == 0) pk0[ai][m] = o;
                    else {
                        if (m > 0 || fr >= 2) { u32x4 o4; o4[0] = pk0[ai][m][0]; o4[1] = pk0[ai][m][1]; o4[2] = o[0]; o4[3] = o[1]; *(u32x4*)(F + (size_t)tk * DFF + ch0) = o4; }
                        if ((m == 0 && fr < 2) || (m == 3 && fr >= 14)) {
                            bf16_t* hp = HT + ((size_t)grp * 4 + ((m == 0) ? fr : (fr - 12))) * (2 * DFF) + ch0;
                            u32x4 og, ov;
#pragma unroll
                            for (int nn = 0; nn < 2; ++nn) { og[2 * nn] = cvt_pk(acc[ai][0][m][nn][0], acc[ai][0][m][nn][1]); og[2 * nn + 1] = cvt_pk(acc[ai][0][m][nn][2], acc[ai][0][m][nn][3]);
                                ov[2 * nn] = cvt_pk(acc[ai][1][m][nn][0], acc[ai][1][m][nn][1]); ov[2 * nn + 1] = cvt_pk(acc[ai][1][m][nn][2], acc[ai][1][m][nn][3]); }
                            *(u32x4*)hp = og; *(u32x4*)(hp + DFF) = ov; } }
                }
            }
        }
    }
};
__device__ void conv_seams(const Params& p) {
    const bf16_t* __restrict__ HT = (const bf16_t*)(p.ws + OFF_HT); bf16_t* __restrict__ F = (bf16_t*)(p.ws + OFF_F);
    const float* __restrict__ cw = p.conv_w; const float* __restrict__ cb = p.conv_b;
    for (int it = blockIdx.x * NTH + tid_opaque(); it < 512 * 704; it += NWG * NTH) {
        const int c4 = it % 704, g = it / 704, ch = 4 * c4; const bool first = ((g * 64) & (SEQ - 1)) == 0;
        f32x4 w0[2], w1[2], w2[2], bb[2], h0[2], h1[2], t0[2], t1[2];
#pragma unroll
        for (int bj = 0; bj < 2; ++bj) { const int cc = bj * DFF + ch;
            w0[bj] = *(const f32x4*)(cw + cc); w1[bj] = *(const f32x4*)(cw + 2 * DFF + cc); w2[bj] = *(const f32x4*)(cw + 4 * DFF + cc); bb[bj] = *(const f32x4*)(cb + cc);
            h0[bj] = bf4_to_f32(*(const u32x2*)(HT + ((size_t)g * 4 + 0) * (2 * DFF) + cc)); h1[bj] = bf4_to_f32(*(const u32x2*)(HT + ((size_t)g * 4 + 1) * (2 * DFF) + cc));
            t0[bj] = (f32x4){0.f, 0.f, 0.f, 0.f}; t1[bj] = (f32x4){0.f, 0.f, 0.f, 0.f};
            if (!first) { t0[bj] = bf4_to_f32(*(const u32x2*)(HT + ((size_t)(g - 1) * 4 + 2) * (2 * DFF) + cc)); t1[bj] = bf4_to_f32(*(const u32x2*)(HT + ((size_t)(g - 1) * 4 + 3) * (2 * DFF) + cc)); } }
        f32x4 u0[2], u1[2];
#pragma unroll
        for (int bj = 0; bj < 2; ++bj) { u0[bj] = bb[bj] + w0[bj] * t0[bj] + w1[bj] * t1[bj] + w2[bj] * h0[bj]; u1[bj] = bb[bj] + w0[bj] * t1[bj] + w1[bj] * h0[bj] + w2[bj] * h1[bj]; }
        u32x2 o; o[0] = cvt_pk(gelu_f(u0[0][0]) * u0[1][0], gelu_f(u0[0][1]) * u0[1][1]); o[1] = cvt_pk(gelu_f(u0[0][2]) * u0[1][2], gelu_f(u0[0][3]) * u0[1][3]);
        *(u32x2*)(F + (size_t)(g * 64) * DFF + ch) = o;
        o[0] = cvt_pk(gelu_f(u1[0][0]) * u1[1][0], gelu_f(u1[0][1]) * u1[1][1]); o[1] = cvt_pk(gelu_f(u1[0][2]) * u1[1][2], gelu_f(u1[0][3]) * u1[1][3]);
        *(u32x2*)(F + (size_t)(g * 64 + 1) * DFF + ch) = o;
    }
}

__device__ __forceinline__ int colmap(int mat, int n) {
    if (mat == 0) {
        if (n < 5120) { const int h = n / 1280, w = n - h * 1280, t = w >> 8, x = w & 255;
            if (t == 0) return (x < 128) ? (h * 128 + x) : (512 + h * 128 + (x - 128));
            if (t == 1) return 1024 + h * 256 + x;
            if (t == 2) return (x < 128) ? (2048 + h * 256 + x) : (4368 + h * 256 + (x - 128));
            if (t == 3) return (x < 128) ? (2048 + h * 256 + 128 + x) : (4368 + h * 256 + 128 + (x - 128));
            return 5392 + h * 256 + x; }
        if (n < 6144) return 3088 + (n - 5120); if (n < 6400) return 4112 + (n - 6144); if (n < 6416) return 3072 + (n - 6400); return -1; }
    if (mat == 2) { const int pn = n >> 8, w = n & 255; return (w < 128) ? (pn * 128 + w) : (DFF + pn * 128 + (w - 128)); }
    return n;
}
struct P0Tile { int mat; const float* W; int ldw; bf16_t* dst; int Kd, k0, n0; };
__device__ __forceinline__ P0Tile p0_desc(const Params& p, int id) {
    bf16_t* win = (bf16_t*)(p.ws + OFF_WIN); bf16_t* wo = (bf16_t*)(p.ws + OFF_WO); bf16_t* wup = (bf16_t*)(p.ws + OFF_WUP); bf16_t* wdn = (bf16_t*)(p.ws + OFF_WDN);
    if (id < 1664) return P0Tile{0, p.w_in, 6416, win, 1024, (id & 15) * 64, (id >> 4) * 64};
    if (id < 1920) { const int j = id - 1664; return P0Tile{1, p.w_o, 1024, wo, 1024, (j & 15) * 64, (j >> 4) * 64}; }
    if (id < 3328) { const int j = id - 1920; return P0Tile{2, p.w_up, 2 * DFF, wup, 1024, (j & 15) * 64, (j >> 4) * 64}; }
    const int j = id - 3328; return P0Tile{3, p.w_down, 1024, wdn, DFF, (j % 44) * 64, (j / 44) * 64};
}
__device__ __forceinline__ void p0_load(const P0Tile& t, f32x4 (&v)[2]) {
    const int tid = tid_opaque();
#pragma unroll
    for (int i = 0; i < 2; ++i) { const int idx = tid + 512 * i, kl = idx >> 4, n4 = (idx & 15) * 4; const int oc = colmap(t.mat, t.n0 + n4);
        v[i] = (f32x4){0.f, 0.f, 0.f, 0.f}; if (oc >= 0) v[i] = __builtin_nontemporal_load((const f32x4*)(t.W + (size_t)(t.k0 + kl) * t.ldw + oc));
        const float sc = (t.mat == 0 && t.n0 + n4 < 5120 && ((t.n0 + n4) % 1280) < 128) ? 0.08838834764831845f : 1.f; v[i] = v[i] * sc; }
}
__device__ void weight_tiles(const Params& p, LAS unsigned char* lds, int id0, int id1) {
    const int tid = tid_opaque(), w = blockIdx.x;
    if (id0 + w >= id1) return;
    f32x4 v[2]; P0Tile t = p0_desc(p, id0 + w); p0_load(t, v);
    int par = 0;
    __syncthreads();
    for (int id = id0 + w; id < id1; id += NWG, par ^= 1) {
        LAS float* sT = (LAS float*)lds + par * (64 * 65 + 16);
#pragma unroll
        for (int i = 0; i < 2; ++i) { const int idx = tid + 512 * i, kl = idx >> 4, n4 = (idx & 15) * 4;
            sT[kl * 65 + n4 + 0] = v[i][0]; sT[kl * 65 + n4 + 1] = v[i][1]; sT[kl * 65 + n4 + 2] = v[i][2]; sT[kl * 65 + n4 + 3] = v[i][3]; }
        const P0Tile tc = t;
        if (id + NWG < id1) { t = p0_desc(p, id + NWG); p0_load(t, v); }
        __syncthreads();
        const int nl = tid >> 3, kc = tid & 7; u32x4 pk;
#pragma unroll
        for (int e = 0; e < 4; ++e) pk[e] = cvt_pk(sT[(kc * 8 + 2 * e) * 65 + nl], sT[(kc * 8 + 2 * e + 1) * 65 + nl]);
        *(u32x4*)(tc.dst + (size_t)(tc.n0 + nl) * tc.Kd + tc.k0 + kc * 8) = pk;
    }
    __syncthreads();
}
__device__ void phase0(const Params& p, LAS unsigned char* lds) {
    LAS float* sT = (LAS float*)lds; const int tid = tid_opaque(), w = blockIdx.x;
    if (w < 192) { const int cbk = w % 12, ks = w / 12; LAS float* sc = sT;
        if (tid < 256) { const float cv = p.c[(tid >> 6) * DM + ks * 64 + (tid & 63)]; sc[tid] = cv / (1.f + __expf(-cv)); }
        __syncthreads();
        const int col = cbk * 512 + tid; float a0 = 0.f, a1 = 0.f, a2 = 0.f, a3 = 0.f;
#pragma unroll 32
        for (int kk = 0; kk < 64; ++kk) { const float wv = __builtin_nontemporal_load(p.w_ada + (size_t)(ks * 64 + kk) * 6144 + col); a0 += sc[kk] * wv; a1 += sc[64 + kk] * wv; a2 += sc[128 + kk] * wv; a3 += sc[192 + kk] * wv; }
        float* mp = (float*)(p.ws + OFF_MODP) + (size_t)ks * 4 * 6144 + col; mp[0] = a0; mp[6144] = a1; mp[2 * 6144] = a2; mp[3 * 6144] = a3;
        __syncthreads();
    }
    { const float invf[8] = {1.0f, 0.1939227432012558f, 0.03760603070259094f, 0.007292664609849453f, 0.0014142135623842478f, 0.00027424818836152554f, 5.318296098266728e-05f, 1.0313386155758053e-05f};
        float* rope = (float*)(p.ws + OFF_ROPE);
#pragma unroll
        for (int it = 0; it < 2; ++it) { const int idx = w * 512 + tid + it * 131072, t = idx >> 3, i = idx & 7;
            float fi = invf[0];
#pragma unroll
            for (int q = 1; q < 8; ++q) fi = (i == q) ? invf[q] : fi;
            const float ang = (float)p.pos[t] * fi;
            const double nrev = rint((double)ang * 0.15915494309189535); const float r = (float)fma(-nrev, 6.283185307179586, (double)ang);
            rope[t * 16 + i] = __cosf(r); rope[t * 16 + 8 + i] = __sinf(r); } }
}

__device__ void phase_ln_in(const Params& p, LAS unsigned char* lds) {
    LAS float* s_scale = (LAS float*)lds; LAS float* s_shift = s_scale + 1024;
    const int tid = tid_opaque(), w = blockIdx.x, lane = tid & 63, wid = tid >> 6, b = w >> 6;
    const float* modp = (const float*)(p.ws + OFF_MODP);
    f32x4 nx[4][4];
#pragma unroll
    for (int pr = 0; pr < 3; ++pr)
#pragma unroll
        for (int i = 0; i < 4; ++i) nx[pr][i] = __builtin_nontemporal_load((const f32x4*)(p.x + (size_t)(w * 128 + wid * 16 + pr) * DM + i * 256 + lane * 4));
    for (int cc = tid; cc < 1024; cc += 512) { float a = p.b_ada[1024 + cc], s = p.b_ada[cc];
        for (int ks = 0; ks < 16; ++ks) { a += modp[(size_t)(ks * 4 + b) * 6144 + 1024 + cc]; s += modp[(size_t)(ks * 4 + b) * 6144 + cc]; }
        s_scale[cc] = 1.f + a; s_shift[cc] = s; }
    { const int idx = w * 512 + tid; if (idx < 24576) { const int bb = idx / 6144, j = idx % 6144; float a = p.b_ada[j];
            for (int ks = 0; ks < 16; ++ks) a += modp[(size_t)(ks * 4 + bb) * 6144 + j];
            ((float*)(p.ws + OFF_MODF))[idx] = a; } }
    __syncthreads();
    bf16_t* H = (bf16_t*)((unsigned char*)p.out + OO_H);
#pragma unroll
    for (int rr = 0; rr < 16; ++rr) { const int row = w * 128 + wid * 16 + rr; f32x4 v[4];
        if (rr + 3 < 16) {
#pragma unroll
            for (int i = 0; i < 4; ++i) nx[(rr + 3) & 3][i] = __builtin_nontemporal_load((const f32x4*)(p.x + (size_t)(row + 3) * DM + i * 256 + lane * 4)); }
#pragma unroll
        for (int i = 0; i < 4; ++i) v[i] = nx[rr & 3][i];
        float s = 0.f;
#pragma unroll
        for (int i = 0; i < 4; ++i) s += v[i][0] + v[i][1] + v[i][2] + v[i][3];
        const float mu = wave_sum(s) * (1.f / 1024.f); float q = 0.f;
#pragma unroll
        for (int i = 0; i < 4; ++i) { v[i] = v[i] - mu; q += v[i][0] * v[i][0] + v[i][1] * v[i][1] + v[i][2] * v[i][2] + v[i][3] * v[i][3]; }
        const float rstd = rsqrtf(wave_sum(q) * (1.f / 1024.f) + 1e-5f);
#pragma unroll
        for (int i = 0; i < 4; ++i) { const int c0 = i * 256 + lane * 4; const f32x4 sc = *(const LAS f32x4*)(s_scale + c0), sh = *(const LAS f32x4*)(s_shift + c0);
            const f32x4 hv = v[i] * rstd * sc + sh; u32x2 o; o[0] = cvt_pk(hv[0], hv[1]); o[1] = cvt_pk(hv[2], hv[3]); *(u32x2*)(H + (size_t)row * DM + c0) = o; }
    }
}

__device__ void phase_ln_mid(const Params& p) {
    const int tid = tid_opaque(), w = blockIdx.x, lane = tid & 63, wid = tid >> 6, b = w >> 6;
    const float* modf = (const float*)(p.ws + OFF_MODF) + b * 6144;
    bf16_t* H2 = (bf16_t*)(p.ws + OFF_H2); _Float16* X1H = (_Float16*)(p.ws + OFF_X1); const bf16_t* ACC = (const bf16_t*)(p.ws + OFF_ACC1);
    f32x4 g1[4], b1[4], sc2[4], sh2[4], gt[4];
#pragma unroll
    for (int i = 0; i < 4; ++i) { const int c0 = i * 256 + lane * 4; g1[i] = *(const f32x4*)(p.ln1g + c0); b1[i] = *(const f32x4*)(p.ln1b + c0);
        sc2[i] = *(const f32x4*)(modf + 4 * 1024 + c0) + 1.f; sh2[i] = *(const f32x4*)(modf + 3 * 1024 + c0); gt[i] = *(const f32x4*)(modf + 2 * 1024 + c0); }
    const size_t r0 = (size_t)(w * 128 + wid * 16) * DM;
    f32x4 nx[4][4]; u32x2 na[4][4];
#pragma unroll
    for (int pr = 0; pr < 3; ++pr)
#pragma unroll
        for (int i = 0; i < 4; ++i) { nx[pr][i] = __builtin_nontemporal_load((const f32x4*)(p.x + r0 + pr * DM + i * 256 + lane * 4)); na[pr][i] = __builtin_nontemporal_load((const u32x2*)(ACC + r0 + pr * DM + i * 256 + lane * 4)); }
#pragma unroll
    for (int rr = 0; rr < 16; ++rr) { const size_t ro = r0 + (size_t)rr * DM; f32x4 v[4];
        if (rr + 3 < 16) {
#pragma unroll
            for (int i = 0; i < 4; ++i) { nx[(rr + 3) & 3][i] = __builtin_nontemporal_load((const f32x4*)(p.x + ro + 3 * DM + i * 256 + lane * 4)); na[(rr + 3) & 3][i] = __builtin_nontemporal_load((const u32x2*)(ACC + ro + 3 * DM + i * 256 + lane * 4)); } }
#pragma unroll
        for (int i = 0; i < 4; ++i) v[i] = nx[rr & 3][i] * ALPHA + gt[i] * bf4_to_f32(na[rr & 3][i]);
        float s = 0.f;
#pragma unroll
        for (int i = 0; i < 4; ++i) s += v[i][0] + v[i][1] + v[i][2] + v[i][3];
        float mu = wave_sum(s) * (1.f / 1024.f); float q = 0.f;
#pragma unroll
        for (int i = 0; i < 4; ++i) { v[i] = v[i] - mu; q += v[i][0] * v[i][0] + v[i][1] * v[i][1] + v[i][2] * v[i][2] + v[i][3] * v[i][3]; }
        float rstd = rsqrtf(wave_sum(q) * (1.f / 1024.f) + 1e-5f);
        s = 0.f;
#pragma unroll
        for (int i = 0; i < 4; ++i) { v[i] = v[i] * rstd * g1[i] + b1[i]; s += v[i][0] + v[i][1] + v[i][2] + v[i][3];
            f16x4 hx; hx[0] = (_Float16)v[i][0]; hx[1] = (_Float16)v[i][1]; hx[2] = (_Float16)v[i][2]; hx[3] = (_Float16)v[i][3];
            __builtin_nontemporal_store(hx, (f16x4*)(X1H + ro + i * 256 + lane * 4)); }
        mu = wave_sum(s) * (1.f / 1024.f); q = 0.f;
#pragma unroll
        for (int i = 0; i < 4; ++i) { v[i] = v[i] - mu; q += v[i][0] * v[i][0] + v[i][1] * v[i][1] + v[i][2] * v[i][2] + v[i][3] * v[i][3]; }
        rstd = rsqrtf(wave_sum(q) * (1.f / 1024.f) + 1e-5f);
#pragma unroll
        for (int i = 0; i < 4; ++i) { const f32x4 hv = v[i] * rstd * sc2[i] + sh2[i]; u32x2 o; o[0] = cvt_pk(hv[0], hv[1]); o[1] = cvt_pk(hv[2], hv[3]);
            *(u32x2*)(H2 + ro + i * 256 + lane * 4) = o; }
    }
}
__device__ void phase_ln_out(const Params& p) {
    const int tid = tid_opaque(), w = blockIdx.x, lane = tid & 63, wid = tid >> 6, b = w >> 6;
    const float* modf = (const float*)(p.ws + OFF_MODF) + b * 6144;
    const _Float16* X1H = (const _Float16*)(p.ws + OFF_X1); const bf16_t* ACC2 = (const bf16_t*)(p.ws + OFF_H2);
    f32x4 g2[4], b2[4], gt2[4];
#pragma unroll
    for (int i = 0; i < 4; ++i) { const int c0 = i * 256 + lane * 4; g2[i] = *(const f32x4*)(p.ln2g + c0); b2[i] = *(const f32x4*)(p.ln2b + c0); gt2[i] = *(const f32x4*)(modf + 5 * 1024 + c0); }
    const size_t r0 = (size_t)(w * 128 + wid * 16) * DM;
    f16x4 nx[4][4]; u32x2 nb[4][4];
#pragma unroll
    for (int pr = 0; pr < 3; ++pr)
#pragma unroll
        for (int i = 0; i < 4; ++i) { nx[pr][i] = __builtin_nontemporal_load((const f16x4*)(X1H + r0 + pr * DM + i * 256 + lane * 4)); nb[pr][i] = __builtin_nontemporal_load((const u32x2*)(ACC2 + r0 + pr * DM + i * 256 + lane * 4)); }
#pragma unroll
    for (int rr = 0; rr < 16; ++rr) { const size_t ro = r0 + (size_t)rr * DM; f32x4 v[4];
        if (rr + 3 < 16) {
#pragma unroll
            for (int i = 0; i < 4; ++i) { nx[(rr + 3) & 3][i] = __builtin_nontemporal_load((const f16x4*)(X1H + ro + 3 * DM + i * 256 + lane * 4)); nb[(rr + 3) & 3][i] = __builtin_nontemporal_load((const u32x2*)(ACC2 + ro + 3 * DM + i * 256 + lane * 4)); } }
#pragma unroll
        for (int i = 0; i < 4; ++i) { const f16x4 hx = nx[rr & 3][i]; const f32x4 x1 = {(float)hx[0], (float)hx[1], (float)hx[2], (float)hx[3]}; v[i] = x1 * ALPHA + gt2[i] * bf4_to_f32(nb[rr & 3][i]); }
        float s = 0.f;
#pragma unroll
        for (int i = 0; i < 4; ++i) s += v[i][0] + v[i][1] + v[i][2] + v[i][3];
        const float mu = wave_sum(s) * (1.f / 1024.f); float q = 0.f;
#pragma unroll
        for (int i = 0; i < 4; ++i) { v[i] = v[i] - mu; q += v[i][0] * v[i][0] + v[i][1] * v[i][1] + v[i][2] * v[i][2] + v[i][3] * v[i][3]; }
        const float rstd = rsqrtf(wave_sum(q) * (1.f / 1024.f) + 1e-5f);
#pragma unroll
        for (int i = 0; i < 4; ++i) __builtin_nontemporal_store(v[i] * rstd * g2[i] + b2[i], (f32x4*)(p.out + ro + i * 256 + lane * 4));
    }
}

__device__ __forceinline__ u32x2 lds_tr_read0(unsigned addr) { u32x2 r; asm volatile("ds_read_b64_tr_b16 %0, %1\n\ts_waitcnt lgkmcnt(0)" : "=&v"(r) : "v"(addr) : "memory"); return r; }
__device__ __forceinline__ void lds_tr_read4(unsigned a0, unsigned a1, unsigned a2, unsigned a3, u32x2& r0, u32x2& r1, u32x2& r2, u32x2& r3) {
    asm volatile("ds_read_b64_tr_b16 %0, %4\n\tds_read_b64_tr_b16 %1, %5\n\tds_read_b64_tr_b16 %2, %6\n\tds_read_b64_tr_b16 %3, %7\n\ts_waitcnt lgkmcnt(0)"
                 : "=&v"(r0), "=&v"(r1), "=&v"(r2), "=&v"(r3) : "v"(a0), "v"(a1), "v"(a2), "v"(a3) : "memory"); }
template <int OFF> __device__ __forceinline__ u32x2 lds_tr_read(unsigned addr) { u32x2 r; asm volatile("ds_read_b64_tr_b16 %0, %1 offset:%2\n\ts_waitcnt lgkmcnt(0)" : "=&v"(r) : "v"(addr), "i"(OFF) : "memory"); return r; }
__device__ __forceinline__ void tr_frags4(unsigned base, unsigned rs, bf16x8 (&fr)[4]) {
    u32x2 r0, r1, r2, r3; u32x4 t;
    lds_tr_read4(base, base + 4 * rs, base + 16 * rs, base + 20 * rs, r0, r1, r2, r3);
    t[0] = r0[0]; t[1] = r0[1]; t[2] = r1[0]; t[3] = r1[1]; fr[0] = __builtin_bit_cast(bf16x8, t); t[0] = r2[0]; t[1] = r2[1]; t[2] = r3[0]; t[3] = r3[1]; fr[1] = __builtin_bit_cast(bf16x8, t);
    lds_tr_read4(base + 32 * rs, base + 36 * rs, base + 48 * rs, base + 52 * rs, r0, r1, r2, r3);
    t[0] = r0[0]; t[1] = r0[1]; t[2] = r1[0]; t[3] = r1[1]; fr[2] = __builtin_bit_cast(bf16x8, t); t[0] = r2[0]; t[1] = r2[1]; t[2] = r3[0]; t[3] = r3[1]; fr[3] = __builtin_bit_cast(bf16x8, t);
}
__device__ __forceinline__ void swa_unit(const Params& p, int unit, LAS unsigned char* lds, const bool inplace_ok) {
    const int kvh = unit & 1, n = (unit >> 1) & 63, b = unit >> 7;
    LAS bf16_t* Ks = (LAS bf16_t*)lds;
    LAS unsigned char* Vs = (LAS unsigned char*)(Ks + 256 * 72);
    bf16_t* proj = (bf16_t*)(p.ws + OFF_PROJ); const float* rope = (const float*)(p.ws + OFF_ROPE);
    const int tid = tid_opaque(), lane = tid & 63, wid = tid >> 6, h = lane >> 5, l31 = lane & 31;
    const int tband0 = b * SEQ + (n - 1) * 128;
    __syncthreads();
#pragma unroll
    for (int i = 0; i < 4; ++i) { const int pidx = tid + 512 * i, key = pidx >> 3, c8 = pidx & 7; const bool valid = (n > 0) || (key >= 128);
        u32x4 o = {0u, 0u, 0u, 0u};
        if (valid) { const int tok = tband0 + key; const bf16_t* src = proj + (size_t)tok * NPJ + C_KB + kvh * 64;
            if (c8 >= 2) o = *(const u32x4*)(src + c8 * 8);
            else { const bf16x8 lo = *(const bf16x8*)(src), hi = *(const bf16x8*)(src + 8); const float* cs = rope + (size_t)tok * 16; float r[8];
#pragma unroll
                for (int e = 0; e < 8; ++e) { const float t1 = bf2f((bf16_t)lo[e]), t2 = bf2f((bf16_t)hi[e]), cc = cs[e], ss = cs[8 + e]; r[e] = (c8 == 0) ? (t1 * cc - t2 * ss) : (t2 * cc + t1 * ss); }
                o[0] = cvt_pk(r[0], r[1]); o[1] = cvt_pk(r[2], r[3]); o[2] = cvt_pk(r[4], r[5]); o[3] = cvt_pk(r[6], r[7]); } }
        *(LAS u32x4*)(Ks + key * 72 + c8 * 8) = o; }
#pragma unroll
    for (int i = 0; i < 4; ++i) { const int pidx = tid + 512 * i, key = pidx >> 3, c8 = pidx & 7; const bool valid = (n > 0) || (key >= 128);
        bf16x8 v = {0, 0, 0, 0, 0, 0, 0, 0};
        if (valid) v = *(const bf16x8*)(proj + (size_t)(tband0 + key) * NPJ + C_VB + kvh * 64 + c8 * 8);
        *(LAS bf16x8*)(Vs + key * 192 + c8 * 16) = v; }
    __syncthreads();
    const int hq = kvh * 8 + wid; const float sink2 = p.sinks[hq] * LOG2E;
    bf16x8 qraw[5]; f32x4 csr[4];
#define SWA_QLOAD(qtn) do { const int tqn = b * SEQ + n * 128 + 32 * (qtn) + l31; const bf16_t* qr = proj + (size_t)tqn * NPJ + C_QB + hq * 64; \
        qraw[0] = *(const bf16x8*)(qr); qraw[1] = *(const bf16x8*)(qr + 8); _Pragma("unroll") for (int s = 1; s < 4; ++s) qraw[1 + s] = *(const bf16x8*)(qr + 16 * s + 8 * h); \
        _Pragma("unroll") for (int j = 0; j < 4; ++j) csr[j] = *(const f32x4*)(rope + (size_t)tqn * 16 + 4 * j); } while (0)
    SWA_QLOAD(0);
    for (int qt = 0; qt < 4; ++qt) {
        const int tq = b * SEQ + n * 128 + 32 * qt + l31; bf16_t* qrow = proj + (size_t)tq * NPJ + C_QB + hq * 64;
        bf16x8 qf[4];
#pragma unroll
        for (int s = 1; s < 4; ++s) qf[s] = qraw[1 + s];
        { const bf16x8 lo = qraw[0], hi = qraw[1]; float r[8];
#pragma unroll
            for (int e = 0; e < 8; ++e) { const float t1 = bf2f((bf16_t)lo[e]), t2 = bf2f((bf16_t)hi[e]), cc = csr[e >> 2][e & 3], ss = csr[2 + (e >> 2)][e & 3]; r[e] = (h == 0) ? (t1 * cc - t2 * ss) : (t2 * cc + t1 * ss); }
            u32x4 o; o[0] = cvt_pk(r[0], r[1]); o[1] = cvt_pk(r[2], r[3]); o[2] = cvt_pk(r[4], r[5]); o[3] = cvt_pk(r[6], r[7]); qf[0] = __builtin_bit_cast(bf16x8, o); }
        if (qt < 3) SWA_QLOAD(qt + 1);
        f32x16 st[5];
        bf16x8 kfr[2][4];
#pragma unroll
        for (int s = 0; s < 4; ++s) kfr[0][s] = *(const LAS bf16x8*)(Ks + (32 * qt + l31) * 72 + 16 * s + 8 * h);
#pragma unroll
        for (int dk = 0; dk < 5; ++dk) { f32x16 a = {0.f, 0.f, 0.f, 0.f, 0.f, 0.f, 0.f, 0.f, 0.f, 0.f, 0.f, 0.f, 0.f, 0.f, 0.f, 0.f};
            if (dk < 4) {
#pragma unroll
                for (int s = 0; s < 4; ++s) kfr[(dk + 1) & 1][s] = *(const LAS bf16x8*)(Ks + (32 * (qt + dk + 1) + l31) * 72 + 16 * s + 8 * h); }
#pragma unroll
            for (int s = 0; s < 4; ++s) a = __builtin_amdgcn_mfma_f32_32x32x16_bf16(kfr[dk & 1][s], qf[s], a, 0, 0, 0);
            st[dk] = a; }
        float mx = -INFINITY;
#pragma unroll
        for (int dk = 0; dk < 5; ++dk) { const bool dead = (n == 0) && (qt + dk < 4);
#pragma unroll
            for (int r = 0; r < 16; ++r) { const int cidx = (r & 3) + 8 * (r >> 2) + 4 * h; bool ok = !dead; if (dk == 0) ok = ok && (cidx > l31); if (dk == 4) ok = ok && (cidx <= l31);
                const float v = ok ? st[dk][r] * (0.125f * LOG2E) : -INFINITY; st[dk][r] = v; mx = fmaxf(mx, v); } }
        mx = fmaxf(mx, __shfl_xor(mx, 32)); mx = fmaxf(mx, sink2);
        float sum = 0.f;
#pragma unroll
        for (int dk = 0; dk < 5; ++dk)
#pragma unroll
            for (int r = 0; r < 16; ++r) { const float pv = __builtin_amdgcn_exp2f(st[dk][r] - mx); st[dk][r] = pv; sum += pv; }
        sum += __shfl_xor(sum, 32); sum += __builtin_amdgcn_exp2f(sink2 - mx);
        const unsigned va = (unsigned)(size_t)Vs + (unsigned)((32 * qt + 4 * h + ((lane & 15) >> 2)) * 192 + (16 * ((lane >> 4) & 1) + 4 * (lane & 3)) * 2);
        f32x16 oacc[2];
#pragma unroll
        for (int dt = 0; dt < 2; ++dt) oacc[dt] = (f32x16){0.f, 0.f, 0.f, 0.f, 0.f, 0.f, 0.f, 0.f, 0.f, 0.f, 0.f, 0.f, 0.f, 0.f, 0.f, 0.f};
#pragma unroll
        for (int dk = 0; dk < 5; ++dk)
#pragma unroll
            for (int s2 = 0; s2 < 2; ++s2) { u32x4 pp;
#pragma unroll
                for (int j = 0; j < 4; ++j) pp[j] = cvt_pk(st[dk][8 * s2 + 2 * j], st[dk][8 * s2 + 2 * j + 1]);
                const bf16x8 pf = __builtin_bit_cast(bf16x8, pp);
                u32x2 vlo[2], vhi[2];
                { const unsigned ab = va + (unsigned)((32 * dk + 16 * s2) * 192); lds_tr_read4(ab, ab + 8 * 192, ab + 64, ab + 8 * 192 + 64, vlo[0], vhi[0], vlo[1], vhi[1]); }
#pragma unroll
                for (int dt = 0; dt < 2; ++dt) { const u32x2 lo = vlo[dt], hi = vhi[dt];
                    u32x4 vv; vv[0] = lo[0]; vv[1] = lo[1]; vv[2] = hi[0]; vv[3] = hi[1];
                    oacc[dt] = __builtin_amdgcn_mfma_f32_32x32x16_bf16(__builtin_bit_cast(bf16x8, vv), pf, oacc[dt], 0, 0, 0); } }
        const float inv = 1.f / sum;
#pragma unroll
        for (int dt = 0; dt < 2; ++dt)
#pragma unroll
            for (int g = 0; g < 4; ++g) { u32x2 o; o[0] = cvt_pk(oacc[dt][4 * g] * inv, oacc[dt][4 * g + 1] * inv); o[1] = cvt_pk(oacc[dt][4 * g + 2] * inv, oacc[dt][4 * g + 3] * inv);
                if (inplace_ok) *(u32x2*)(qrow + 32 * dt + 8 * g + 4 * h) = o; }
    }
}

#undef SWA_QLOAD
__device__ __forceinline__ void gla_a_unit(const Params& p, int unit, LAS unsigned char* lds, const bool inplace_ok) {
    const int sc = unit & 15, hh = (unit >> 4) & 3, b = unit >> 6;
    LAS float* s_w = (LAS float*)lds; LAS float* s_wt = s_w + 2048; LAS float* s_dec = s_wt + 1024; LAS float* s_bl = s_dec + 128; LAS float* s_gs = s_bl + 128;
    LAS bf16_t* Qm = (LAS bf16_t*)(lds + 16384); LAS bf16_t* Km = Qm + 64 * 136; LAS unsigned char* Ko = lds + 51200; LAS unsigned char* Vs = lds + 71680;
    bf16_t* proj = (bf16_t*)(p.ws + OFF_PROJ); float* DEC = (float*)(p.ws + OFF_DEC); float* DSUP = (float*)(p.ws + OFF_DSUP);
    bf16_t* KOT = (bf16_t*)((unsigned char*)p.out + OO_KOT); bf16_t* ABUF = (bf16_t*)((unsigned char*)p.out + OO_ABUF); _Float16* USUP = (_Float16*)((unsigned char*)p.out + OO_USUP);
    const int tid0 = threadIdx.x; int tid = tid0, lane = tid & 63, wid = tid >> 6, h = lane >> 5, l31 = lane & 31, kg = tid & 15, pp = tid >> 4;
    float wtmp[4], btmp = 0.f;
#pragma unroll
    for (int i = 0; i < 4; ++i) { const int idx = tid + 512 * i; wtmp[i] = p.w_lr[(idx >> 7) * 512 + hh * 128 + (idx & 127)]; }
    if (tid < 128) btmp = p.b_lr[hh * 128 + tid];
    f32x16 S[4];
#pragma unroll
    for (int mt = 0; mt < 4; ++mt) S[mt] = (f32x16){0.f, 0.f, 0.f, 0.f, 0.f, 0.f, 0.f, 0.f, 0.f, 0.f, 0.f, 0.f, 0.f, 0.f, 0.f, 0.f};
    const int tbase = b * SEQ + sc * 512, ubase = (b * 4 + hh) * 128 + sc * 8;
    bf16x8 sq[2], sk[2], sl[2][2], sv[4];
#define GLA_ISSUE(c8n) do { const int t0n = tbase + (c8n) * 64; \
        _Pragma("unroll") for (int j = 0; j < 2; ++j) { const bf16_t* row = proj + (size_t)(t0n + 2 * pp + j) * NPJ; \
            sq[j] = __builtin_nontemporal_load((const bf16x8*)(row + hh * HB + H_Q + 8 * kg)); sk[j] = __builtin_nontemporal_load((const bf16x8*)(row + hh * HB + H_K + 8 * kg)); sl[j][0] = __builtin_nontemporal_load((const bf16x8*)(row + C_LR)); sl[j][1] = __builtin_nontemporal_load((const bf16x8*)(row + C_LR + 8)); } \
        } while (0)
#define GLA_ISSUE_V(c8n) do { const int t0n = tbase + (c8n) * 64; \
        _Pragma("unroll") for (int i = 0; i < 4; ++i) { const int pidx = tid + 512 * i; sv[i] = __builtin_nontemporal_load((const bf16x8*)(proj + (size_t)(t0n + (pidx >> 5)) * NPJ + hh * HB + H_V + (pidx & 31) * 8)); } } while (0)
    GLA_ISSUE(0); GLA_ISSUE_V(0);
    __syncthreads();
#pragma unroll
    for (int i = 0; i < 4; ++i) s_w[tid + 512 * i] = wtmp[i];
    if (tid < 128) { s_bl[tid] = btmp; s_gs[tid] = 0.f; }
    __syncthreads();
    for (int c8 = 0; c8 < 8; ++c8) {
        const int t0 = tbase + c8 * 64, u = ubase + c8;
        tid = tid0; asm volatile("" : "+v"(tid));
        lane = tid & 63; wid = __builtin_amdgcn_readfirstlane(tid >> 6); h = lane >> 5; l31 = lane & 31; kg = tid & 15; pp = tid >> 4;
        const int grp = lane >> 4;
        lds_barrier();
#pragma unroll
        for (int i = 0; i < 4; ++i) { const int pidx = tid + 512 * i; *(LAS bf16x8*)(Vs + (pidx >> 5) * 576 + (pidx & 31) * 16) = sv[i]; }
        if (c8 < 7) GLA_ISSUE_V(c8 + 1);
        float z[2][8];
        { const f32x4 b0 = *(const LAS f32x4*)(s_bl + 8 * kg), b1 = *(const LAS f32x4*)(s_bl + 8 * kg + 4);
#pragma unroll
            for (int j = 0; j < 2; ++j)
#pragma unroll
                for (int e = 0; e < 4; ++e) { z[j][e] = b0[e]; z[j][4 + e] = b1[e]; } }
#pragma unroll
        for (int r = 0; r < 16; ++r) { const f32x4 w0 = *(const LAS f32x4*)(s_w + r * 128 + 8 * kg), w1 = *(const LAS f32x4*)(s_w + r * 128 + 8 * kg + 4);
#pragma unroll
            for (int j = 0; j < 2; ++j) { const float f = bf2f((bf16_t)sl[j][r >> 3][r & 7]);
#pragma unroll
                for (int e = 0; e < 4; ++e) { z[j][e] += f * w0[e]; z[j][4 + e] += f * w1[e]; } } }
        float c0[8], tot[8], sN[8];
#pragma unroll
        for (int e = 0; e < 8; ++e) {
            const float la0 = -(fmaxf(-z[0][e], 0.f) * (0.0625f * LOG2E) + __builtin_amdgcn_logf(1.f + __builtin_amdgcn_exp2f(-fabsf(z[0][e]) * LOG2E)) * 0.0625f),
                        la1 = -(fmaxf(-z[1][e], 0.f) * (0.0625f * LOG2E) + __builtin_amdgcn_logf(1.f + __builtin_amdgcn_exp2f(-fabsf(z[1][e]) * LOG2E)) * 0.0625f);
            c0[e] = la0; tot[e] = la0 + la1; float sv_ = tot[e];
            float t = __shfl_up(sv_, 16); if (grp >= 1) sv_ += t;
            t = __shfl_up(sv_, 32); if (grp >= 2) sv_ += t;
            sN[e] = sv_; }
        if (grp == 3) { f32x4 a0, a1;
#pragma unroll
            for (int e = 0; e < 4; ++e) { a0[e] = sN[e]; a1[e] = sN[4 + e]; }
            *(LAS f32x4*)(s_wt + wid * 128 + 8 * kg) = a0; *(LAS f32x4*)(s_wt + wid * 128 + 8 * kg + 4) = a1; }
        lds_barrier();
        float g0[8], gmid[8], glast[8];
#pragma unroll
        for (int e = 0; e < 8; ++e) { g0[e] = sN[e] - tot[e] + c0[e]; glast[e] = 0.f; gmid[e] = 0.f; }
#pragma unroll
        for (int w2 = 0; w2 < 8; ++w2) { const f32x4 a0 = *(const LAS f32x4*)(s_wt + w2 * 128 + 8 * kg), a1 = *(const LAS f32x4*)(s_wt + w2 * 128 + 8 * kg + 4);
            if (w2 == wid) {
#pragma unroll
                for (int e = 0; e < 8; ++e) g0[e] += glast[e]; }
#pragma unroll
            for (int e = 0; e < 8; ++e) glast[e] += (e < 4) ? a0[e & 3] : a1[e & 3];
            if (w2 == 3) {
#pragma unroll
                for (int e = 0; e < 8; ++e) gmid[e] = glast[e]; } }
#pragma unroll
        for (int j = 0; j < 2; ++j) { const int tok = 2 * pp + j; u32x4 o4; float gg[8];
#pragma unroll
            for (int e = 0; e < 8; ++e) gg[e] = g0[e] + ((j == 0) ? 0.f : (tot[e] - c0[e]));
#pragma unroll
            for (int e = 0; e < 4; ++e) o4[e] = cvt_pk(bf2f((bf16_t)sq[j][2 * e]) * __builtin_amdgcn_exp2f(gg[2 * e]), bf2f((bf16_t)sq[j][2 * e + 1]) * __builtin_amdgcn_exp2f(gg[2 * e + 1]));
            if (inplace_ok) *(u32x4*)(proj + (size_t)(t0 + tok) * NPJ + hh * HB + H_Q + 8 * kg) = o4;
#pragma unroll
            for (int e = 0; e < 4; ++e) o4[e] = cvt_pk(bf2f((bf16_t)sq[j][2 * e]) * __builtin_amdgcn_exp2f(gg[2 * e] - gmid[2 * e]), bf2f((bf16_t)sq[j][2 * e + 1]) * __builtin_amdgcn_exp2f(gg[2 * e + 1] - gmid[2 * e + 1]));
            *(LAS u32x4*)(Qm + tok * 136 + 8 * kg) = o4;
#pragma unroll
            for (int e = 0; e < 4; ++e) o4[e] = cvt_pk(bf2f((bf16_t)sk[j][2 * e]) * __builtin_amdgcn_exp2f(gmid[2 * e] - gg[2 * e]), bf2f((bf16_t)sk[j][2 * e + 1]) * __builtin_amdgcn_exp2f(gmid[2 * e + 1] - gg[2 * e + 1]));
            *(LAS u32x4*)(Km + tok * 136 + 8 * kg) = o4;
#pragma unroll
            for (int e = 0; e < 4; ++e) o4[e] = cvt_pk(bf2f((bf16_t)sk[j][2 * e]) * __builtin_amdgcn_exp2f(glast[2 * e] - gg[2 * e]), bf2f((bf16_t)sk[j][2 * e + 1]) * __builtin_amdgcn_exp2f(glast[2 * e + 1] - gg[2 * e + 1]));
            *(LAS u32x4*)(Ko + tok * 320 + kg * 16) = o4; *(u32x4*)(KOT + ((size_t)u * 64 + tok) * 128 + 8 * kg) = o4; }
        if (pp == 0) { f32x4 d0, d1;
#pragma unroll
            for (int e = 0; e < 4; ++e) { d0[e] = __builtin_amdgcn_exp2f(glast[e]); d1[e] = __builtin_amdgcn_exp2f(glast[4 + e]); }
            { f32x4 s0 = *(const LAS f32x4*)(s_gs + 8 * kg), s1 = *(const LAS f32x4*)(s_gs + 8 * kg + 4);
#pragma unroll
                for (int e = 0; e < 4; ++e) { s0[e] += glast[e]; s1[e] += glast[4 + e]; }
                *(LAS f32x4*)(s_gs + 8 * kg) = s0; *(LAS f32x4*)(s_gs + 8 * kg + 4) = s1; }
            *(LAS f32x4*)(s_dec + 8 * kg) = d0; *(LAS f32x4*)(s_dec + 8 * kg + 4) = d1; *(f32x4*)(DEC + u * 128 + 8 * kg) = d0; *(f32x4*)(DEC + u * 128 + 8 * kg + 4) = d1; }
        if (c8 < 7) GLA_ISSUE(c8 + 1);
        lds_barrier();
        { const int mi = wid >> 1, fr = lane & 15, fq = lane >> 4;
#pragma unroll
            for (int nn = 0; nn < 2; ++nn) { const int nj = 2 * (wid & 1) + nn; f32x4 a = {0.f, 0.f, 0.f, 0.f};
                if (nj <= mi) {
#pragma unroll
                    for (int s = 0; s < 4; ++s) { const bf16x8 qa = *(const LAS bf16x8*)(Qm + (16 * mi + fr) * 136 + 32 * s + 8 * fq), ka = *(const LAS bf16x8*)(Km + (16 * nj + fr) * 136 + 32 * s + 8 * fq);
                        a = __builtin_amdgcn_mfma_f32_16x16x32_bf16(ka, qa, a, 0, 0, 0); } }
                const int ii = 16 * mi + fr, j0 = 16 * nj + 4 * fq; u32x2 o;
                o[0] = cvt_pk((j0 + 0 <= ii) ? a[0] : 0.f, (j0 + 1 <= ii) ? a[1] : 0.f); o[1] = cvt_pk((j0 + 2 <= ii) ? a[2] : 0.f, (j0 + 3 <= ii) ? a[3] : 0.f);
                *(u32x2*)(ABUF + (size_t)u * 4096 + ii * 64 + j0) = o; } }
#pragma unroll
        for (int mt = 0; mt < 4; ++mt)
#pragma unroll
            for (int g = 0; g < 4; ++g) { const f32x4 d4 = *(const LAS f32x4*)(s_dec + 32 * mt + 8 * g + 4 * h);
#pragma unroll
                for (int e = 0; e < 4; ++e) S[mt][4 * g + e] *= d4[e]; }
        const unsigned trb = (unsigned)((8 * h + ((lane & 15) >> 2)));
        const unsigned trc = (unsigned)((16 * ((lane >> 4) & 1) + 4 * (lane & 3)) * 2);
        bf16x8 vb[4]; tr_frags4((unsigned)(size_t)Vs + trb * 576u + (unsigned)(32 * wid * 2) + trc, 576u, vb);
#pragma unroll
        for (int mt = 0; mt < 4; ++mt) { bf16x8 ka[4]; tr_frags4((unsigned)(size_t)Ko + trb * 320u + (unsigned)(32 * mt * 2) + trc, 320u, ka);
#pragma unroll
            for (int s = 0; s < 4; ++s) S[mt] = __builtin_amdgcn_mfma_f32_32x32x16_bf16(ka[s], vb[s], S[mt], 0, 0, 0); }
    }
#undef GLA_ISSUE
#undef GLA_ISSUE_V
#pragma unroll
    for (int mt = 0; mt < 4; ++mt)
#pragma unroll
        for (int r = 0; r < 16; ++r) USUP[((size_t)unit * 128 + 32 * mt + (r & 3) + 8 * (r >> 2) + 4 * h) * 256 + 32 * wid + l31] = (_Float16)S[mt][r];
    if (pp == 0) {
#pragma unroll
        for (int e = 0; e < 8; ++e) DSUP[unit * 128 + 8 * kg + e] = __builtin_amdgcn_exp2f(s_gs[8 * kg + e]); }
}
__device__ void gla_scan(const Params& p) {
    _Float16* USUP = (_Float16*)((unsigned char*)p.out + OO_USUP); const float* DSUP = (const float*)(p.ws + OFF_DSUP);
    const int e = blockIdx.x * 512 + tid_opaque(), bh = e >> 13, w = e & 8191, kd = w >> 6, v4 = w & 63;
    f16x4 uh[16]; float dd[16];
#pragma unroll
    for (int sc = 0; sc < 16; ++sc) { uh[sc] = __builtin_nontemporal_load((const f16x4*)(USUP + ((size_t)(bh * 16 + sc) * 128 + kd) * 256 + v4 * 4)); dd[sc] = DSUP[(bh * 16 + sc) * 128 + kd]; }
    f32x4 S = {0.f, 0.f, 0.f, 0.f};
#pragma unroll
    for (int sc = 0; sc < 16; ++sc) { f16x4 sh; sh[0] = (_Float16)S[0]; sh[1] = (_Float16)S[1]; sh[2] = (_Float16)S[2]; sh[3] = (_Float16)S[3];
        *(f16x4*)(USUP + ((size_t)(bh * 16 + sc) * 128 + kd) * 256 + v4 * 4) = sh;
        const f32x4 uu = {(float)uh[sc][0], (float)uh[sc][1], (float)uh[sc][2], (float)uh[sc][3]}; S = S * dd[sc] + uu; }
}
__device__ __forceinline__ void gla_b_unit(const Params& p, int unit, LAS unsigned char* lds, const bool inplace_ok) {
    const int sc = unit & 15, hh = (unit >> 4) & 3, b = unit >> 6;
    LAS unsigned char* Ko = lds + 36864; LAS bf16_t* Qi = (LAS bf16_t*)(lds + 57344); LAS bf16_t* As = Qi + 64 * 136; LAS float* s_dec = (LAS float*)(lds + 83968);
    LAS float* Os = (LAS float*)(lds + 84992);
    bf16_t* proj = (bf16_t*)(p.ws + OFF_PROJ); const float* DEC = (const float*)(p.ws + OFF_DEC);
    const bf16_t* KOT = (const bf16_t*)((unsigned char*)p.out + OO_KOT); const bf16_t* ABUF = (const bf16_t*)((unsigned char*)p.out + OO_ABUF); const _Float16* USUP = (const _Float16*)((unsigned char*)p.out + OO_USUP);
    const int tid0 = threadIdx.x; int tid = tid0, lane = tid & 63, wid = tid >> 6, h = lane >> 5, l31 = lane & 31;
    int tokl = tid >> 5, c8i = tid & 31;
    const f32x4 gn0 = *(const f32x4*)(p.gnorm + 8 * c8i), gn1 = *(const f32x4*)(p.gnorm + 8 * c8i + 4);
    bf16x8 sv[4]; u32x4 sk[2], sq[2], sa; float sd = 0.f;
    const int tbase = b * SEQ + sc * 512, ubase = (b * 4 + hh) * 128 + sc * 8;
#define GLB_ISSUE(c8n) do { const int t0n = tbase + (c8n) * 64, un = ubase + (c8n); \
        _Pragma("unroll") for (int i = 0; i < 4; ++i) { const int pidx = tid + 512 * i, tok = pidx >> 5, cc = pidx & 31; sv[i] = __builtin_nontemporal_load((const bf16x8*)(proj + (size_t)(t0n + tok) * NPJ + hh * HB + H_V + cc * 8)); } \
        _Pragma("unroll") for (int i = 0; i < 2; ++i) { const int pidx = tid + 512 * i; sk[i] = __builtin_nontemporal_load((const u32x4*)(KOT + (size_t)un * 8192 + (size_t)pidx * 8)); \
            sq[i] = __builtin_nontemporal_load((const u32x4*)(proj + (size_t)(t0n + (pidx >> 4)) * NPJ + hh * HB + H_Q + (pidx & 15) * 8)); } \
        sa = __builtin_nontemporal_load((const u32x4*)(ABUF + (size_t)un * 4096 + (tid >> 3) * 64 + (tid & 7) * 8)); if (tid < 128) sd = DEC[un * 128 + tid]; } while (0)
    __syncthreads();
    GLB_ISSUE(0);
    f32x16 S[4];
#pragma unroll
    for (int mt = 0; mt < 4; ++mt)
#pragma unroll
        for (int r = 0; r < 16; ++r) S[mt][r] = (float)USUP[((size_t)unit * 128 + 32 * mt + (r & 3) + 8 * (r >> 2) + 4 * h) * 256 + 32 * wid + l31];
    for (int c8 = 0; c8 < 8; ++c8) {
        const int t0 = tbase + c8 * 64;
        tid = tid0; asm volatile("" : "+v"(tid));
        lane = tid & 63; wid = __builtin_amdgcn_readfirstlane(tid >> 6); h = lane >> 5; l31 = lane & 31; tokl = tid >> 5; c8i = tid & 31;
        lds_barrier();
#pragma unroll
        for (int i = 0; i < 4; ++i) { const int pidx = tid + 512 * i, tok = pidx >> 5, cc = pidx & 31; *(LAS bf16x8*)(lds + tok * 576 + cc * 16) = sv[i]; }
#pragma unroll
        for (int i = 0; i < 2; ++i) { const int pidx = tid + 512 * i; *(LAS u32x4*)(Ko + (pidx >> 4) * 320 + (pidx & 15) * 16) = sk[i]; *(LAS u32x4*)(Qi + (pidx >> 4) * 136 + (pidx & 15) * 8) = sq[i]; }
        *(LAS u32x4*)(As + (tid >> 3) * 72 + (tid & 7) * 8) = sa;
        if (tid < 128) s_dec[tid] = sd;
        lds_barrier();
        bf16x8 wa[4], gb[4], yb[4];
#pragma unroll
        for (int ps = 0; ps < 2; ++ps) { const bf16_t* base = proj + (size_t)(t0 + ps * 16 + tokl) * NPJ + 8 * c8i;
            wa[ps] = __builtin_nontemporal_load((const bf16x8*)(base + hh * HB + H_WA)); gb[ps] = __builtin_nontemporal_load((const bf16x8*)(base + hh * HB + H_GB)); yb[ps] = __builtin_nontemporal_load((const bf16x8*)(base + C_QB + hh * 256)); }
        f32x16 o[2];
#pragma unroll
        for (int it = 0; it < 2; ++it) o[it] = (f32x16){0.f, 0.f, 0.f, 0.f, 0.f, 0.f, 0.f, 0.f, 0.f, 0.f, 0.f, 0.f, 0.f, 0.f, 0.f, 0.f};
        const unsigned trb = (unsigned)((8 * h + ((lane & 15) >> 2))), trc = (unsigned)((16 * ((lane >> 4) & 1) + 4 * (lane & 3)) * 2);
        bf16x8 vb[4]; tr_frags4((unsigned)(size_t)lds + trb * 576u + (unsigned)(32 * wid * 2) + trc, 576u, vb);
#pragma unroll
        for (int it = 0; it < 2; ++it)
#pragma unroll
            for (int s = 0; s < 4; ++s) { if (it == 0 && s >= 2) continue; const bf16x8 af = *(const LAS bf16x8*)(As + (32 * it + l31) * 72 + 16 * s + 8 * h); o[it] = __builtin_amdgcn_mfma_f32_32x32x16_bf16(af, vb[s], o[it], 0, 0, 0); }
#pragma unroll
        for (int mt = 0; mt < 4; ++mt) { u32x4 qq[2][2], sp[2];
#pragma unroll
            for (int s2 = 0; s2 < 2; ++s2)
#pragma unroll
                for (int it = 0; it < 2; ++it) { const LAS bf16_t* qp = Qi + (32 * it + l31) * 136 + 32 * mt + 16 * s2 + 4 * h;
                    const u32x2 lo = *(const LAS u32x2*)qp, hi = *(const LAS u32x2*)(qp + 8); qq[s2][it][0] = lo[0]; qq[s2][it][1] = lo[1]; qq[s2][it][2] = hi[0]; qq[s2][it][3] = hi[1]; }
#pragma unroll
            for (int s2 = 0; s2 < 2; ++s2)
#pragma unroll
                for (int j = 0; j < 4; ++j) sp[s2][j] = cvt_pk(S[mt][8 * s2 + 2 * j], S[mt][8 * s2 + 2 * j + 1]);
#pragma unroll
            for (int s2 = 0; s2 < 2; ++s2)
#pragma unroll
                for (int it = 0; it < 2; ++it) o[it] = __builtin_amdgcn_mfma_f32_32x32x16_bf16(__builtin_bit_cast(bf16x8, qq[s2][it]), __builtin_bit_cast(bf16x8, sp[s2]), o[it], 0, 0, 0); }
#pragma unroll
        for (int mt = 0; mt < 4; ++mt)
#pragma unroll
            for (int g = 0; g < 4; ++g) { const f32x4 d4 = *(const LAS f32x4*)(s_dec + 32 * mt + 8 * g + 4 * h);
#pragma unroll
                for (int e = 0; e < 4; ++e) S[mt][4 * g + e] *= d4[e]; }
#pragma unroll
        for (int mt = 0; mt < 4; ++mt) { bf16x8 ka[4]; tr_frags4((unsigned)(size_t)Ko + trb * 320u + (unsigned)(32 * mt * 2) + trc, 320u, ka);
#pragma unroll
            for (int s = 0; s < 4; ++s) S[mt] = __builtin_amdgcn_mfma_f32_32x32x16_bf16(ka[s], vb[s], S[mt], 0, 0, 0); }
#pragma unroll
        for (int ps = 2; ps < 4; ++ps) { const bf16_t* base = proj + (size_t)(t0 + ps * 16 + tokl) * NPJ + 8 * c8i;
            wa[ps] = __builtin_nontemporal_load((const bf16x8*)(base + hh * HB + H_WA)); gb[ps] = __builtin_nontemporal_load((const bf16x8*)(base + hh * HB + H_GB)); yb[ps] = __builtin_nontemporal_load((const bf16x8*)(base + C_QB + hh * 256)); }
#pragma unroll
        for (int it = 0; it < 2; ++it)
#pragma unroll
            for (int r = 0; r < 16; ++r) Os[(32 * it + (r & 3) + 8 * (r >> 2) + 4 * h) * 260 + 32 * wid + l31] = o[it][r];
        lds_barrier();
        if (c8 < 7) GLB_ISSUE(c8 + 1);
#pragma unroll
        for (int ps = 0; ps < 4; ++ps) { const int tok = ps * 16 + tokl; const LAS float* orow = Os + tok * 260 + 8 * c8i;
            const f32x4 o0 = *(const LAS f32x4*)orow, o1 = *(const LAS f32x4*)(orow + 4);
            float ss = o0[0] * o0[0] + o0[1] * o0[1] + o0[2] * o0[2] + o0[3] * o0[3] + o1[0] * o1[0] + o1[1] * o1[1] + o1[2] * o1[2] + o1[3] * o1[3];
            ss += __builtin_bit_cast(float, __builtin_amdgcn_update_dpp(0, __builtin_bit_cast(int, ss), 0xB1, 0xF, 0xF, true));
            ss += __builtin_bit_cast(float, __builtin_amdgcn_update_dpp(0, __builtin_bit_cast(int, ss), 0x4E, 0xF, 0xF, true));
            ss += __builtin_bit_cast(float, __builtin_amdgcn_update_dpp(0, __builtin_bit_cast(int, ss), 0x141, 0xF, 0xF, true));
            ss += __builtin_bit_cast(float, __builtin_amdgcn_update_dpp(0, __builtin_bit_cast(int, ss), 0x140, 0xF, 0xF, true));
            ss += __shfl_xor(ss, 16);
            const float rinv = rsqrtf(ss * (1.f / 256.f) + 1e-6f); float y[8];
#pragma unroll
            for (int e = 0; e < 8; ++e) { const float ovv = (e < 4) ? o0[e & 3] : o1[e & 3], gn = (e < 4) ? gn0[e & 3] : gn1[e & 3];
                y[e] = bf2f((bf16_t)wa[ps][e]) * (ovv * rinv * gn) + sigmoidf_(bf2f((bf16_t)gb[ps][e])) * bf2f((bf16_t)yb[ps][e]); }
            u32x4 o4; o4[0] = cvt_pk(y[0], y[1]); o4[1] = cvt_pk(y[2], y[3]); o4[2] = cvt_pk(y[4], y[5]); o4[3] = cvt_pk(y[6], y[7]);
            if (inplace_ok) *(u32x4*)(proj + (size_t)(t0 + tok) * NPJ + C_QB + hh * 256 + 8 * c8i) = o4; }
    }
#undef GLB_ISSUE
}

__device__ __forceinline__ Params load_params() {
#if defined(__HIP_DEVICE_COMPILE__)
    const __attribute__((address_space(4))) Params* kp = (const __attribute__((address_space(4))) Params*)__builtin_amdgcn_kernarg_segment_ptr();
    asm volatile("" : "+s"(kp)); Params q;
    q.x = kp->x; q.c = kp->c; q.pos = kp->pos; q.w_ada = kp->w_ada; q.b_ada = kp->b_ada; q.w_in = kp->w_in; q.w_lr = kp->w_lr; q.b_lr = kp->b_lr; q.gnorm = kp->gnorm; q.sinks = kp->sinks; q.w_o = kp->w_o;
    q.ln1g = kp->ln1g; q.ln1b = kp->ln1b; q.w_up = kp->w_up; q.conv_w = kp->conv_w; q.conv_b = kp->conv_b; q.w_down = kp->w_down; q.ln2g = kp->ln2g; q.ln2b = kp->ln2b; q.out = kp->out; q.ws = kp->ws;
    return q;
#else
    return Params{};
#endif
}
__global__ void __launch_bounds__(NTH, 2) mega(Params p) {
    extern __shared__ __attribute__((aligned(16))) unsigned char shm[];
    LAS unsigned char* lds = (LAS unsigned char*)shm;
    cg::grid_group grid = cg::this_grid();
    const int w = blockIdx.x;
    volatile LAS unsigned* xst = (volatile LAS unsigned*)(lds + LDS_BYTES - 16);
    if (threadIdx.x == 0) { xst[0] = 0u; xst[1] = 0u; }
    __syncthreads();
    const XcdBarrier xb = xcd_barrier_post((unsigned*)(p.ws + OFF_BAR), xst);
    if (p.ws == nullptr) grid.sync();
#ifndef PROBE_DUP
#define PROBE_DUP 0
#endif
#if PROBE_DUP & 1
    { const Params q = load_params(); phase0(q, lds); }
    xcd_barrier(xb);
    { const Params q = load_params(); phase_ln_in(q, lds); weight_tiles(q, lds, 0, 1664); }
    xcd_barrier(xb);
#endif
    { const Params q = load_params(); phase0(q, lds); }
    xcd_barrier(xb);
    { const Params q = load_params(); phase_ln_in(q, lds); weight_tiles(q, lds, 0, 1664); }
    xcd_barrier(xb);
    { const Params q = load_params(); { bf16_t* proj = (bf16_t*)(q.ws + OFF_PROJ); pg8::Gemm g{(const bf16_t*)((unsigned char*)q.out + OO_H), (const bf16_t*)(q.ws + OFF_WIN), 128, 26, 1024, 1024, 64}; pg8::StaticOrder so; so.init(128, 26, NWG, w); EpiProjIn e{proj}; pg8::gemm_phase(lds, g, so, e); } }
    xcd_barrier(xb);
#if PROBE_DUP & 2
    { const Params q = load_params(); const bool ok = (q.ws == nullptr); for (int u = w; u < 512; u += NWG) swa_unit(q, u, lds, ok); }
    xcd_barrier(xb);
#endif
#if PROBE_DUP & 32
    { const Params q = load_params(); const bool ok = (q.ws == nullptr); gla_a_unit(q, w, lds, ok); }
    xcd_barrier(xb);
#endif
    { const Params q = load_params(); for (int u = w; u < 512; u += NWG) swa_unit(q, u, lds, true); gla_a_unit(q, w, lds, true); }
    xcd_barrier(xb);
    { const Params q = load_params(); gla_scan(q); weight_tiles(q, lds, 1664, 4032); }
    xcd_barrier(xb);
#if PROBE_DUP & 4
    { const Params q = load_params(); const bool ok = (q.ws == nullptr); gla_b_unit(q, w, lds, ok); }
    xcd_barrier(xb);
#endif
    { const Params q = load_params(); gla_b_unit(q, w, lds, true); }
    xcd_barrier(xb);
    { const Params q = load_params(); { bf16_t* proj = (bf16_t*)(q.ws + OFF_PROJ); pg8::Gemm g{proj + C_QB, (const bf16_t*)(q.ws + OFF_WO), 128, 4, 1024, NPJ, 64}; pg8::StaticOrder so; so.init(128, 4, NWG, w); EpiProj e{(bf16_t*)(q.ws + OFF_ACC1), 1024}; pg8::gemm_phase(lds, g, so, e); } }
    xcd_barrier(xb);
#if PROBE_DUP & 8
    { const Params q = load_params(); phase_ln_mid(q); }
    xcd_barrier(xb);
#endif
    { const Params q = load_params(); phase_ln_mid(q); }
    xcd_barrier(xb);
    { const Params q = load_params(); { pg8::Gemm g{(const bf16_t*)(q.ws + OFF_H2), (const bf16_t*)(q.ws + OFF_WUP), 128, 22, 1024, 1024, 64}; pg8::StaticOrder so; so.init(128, 22, NWG, w); EpiUp e{(bf16_t*)(q.ws + OFF_F), q.conv_w, q.conv_b, (bf16_t*)(q.ws + OFF_HT)}; pg8::gemm_phase(lds, g, so, e); } }
    xcd_barrier(xb);
    { const Params q = load_params(); conv_seams(q); }
    xcd_barrier(xb);
    { const Params q = load_params(); { pg8::Gemm g{(const bf16_t*)(q.ws + OFF_F), (const bf16_t*)(q.ws + OFF_WDN), 128, 4, DFF, DFF, 64}; pg8::StaticOrder so; so.init(128, 4, NWG, w); EpiProj e{(bf16_t*)(q.ws + OFF_H2), 1024}; pg8::gemm_phase(lds, g, so, e); } }
    xcd_barrier(xb);
#if PROBE_DUP & 16
    { const Params q = load_params(); phase_ln_out(q); }
    xcd_barrier(xb);
#endif
    { const Params q = load_params(); phase_ln_out(q); }
}

extern "C" void kernel_launch(void* const* d_in, const int* in_sizes, int n_in, void* d_out, int out_size, void* d_ws, size_t ws_size, hipStream_t stream) {
    static int ready = 0;
    if (ready == 0) {
        ready = 1;
        if (n_in != 19 || out_size != T_TOK * DM || ws_size < WS_NEED) { fprintf(stderr, "kernel_launch: unexpected shapes (n_in %d out %d ws %zu need %zu)\n", n_in, out_size, ws_size, (size_t)WS_NEED); ready = -1; }
        else if (hipFuncSetAttribute((const void*)mega, hipFuncAttributeMaxDynamicSharedMemorySize, LDS_BYTES) != hipSuccess) { fprintf(stderr, "kernel_launch: hipFuncSetAttribute failed\n"); ready = -1; }
        else { int per_cu = 0; if (hipOccupancyMaxActiveBlocksPerMultiprocessor(&per_cu, (const void*)mega, NTH, LDS_BYTES) != hipSuccess || per_cu < 1) fprintf(stderr, "kernel_launch: occupancy query says %d blocks/CU\n", per_cu); (void)hipGetLastError(); }
    }
    if (ready < 0) return;
    Params p{};
    p.x = (const float*)d_in[0]; p.c = (const float*)d_in[1]; p.pos = (const int*)d_in[2]; p.w_ada = (const float*)d_in[3]; p.b_ada = (const float*)d_in[4]; p.w_in = (const float*)d_in[5];
    p.w_lr = (const float*)d_in[6]; p.b_lr = (const float*)d_in[7]; p.gnorm = (const float*)d_in[8]; p.sinks = (const float*)d_in[9]; p.w_o = (const float*)d_in[10]; p.ln1g = (const float*)d_in[11];
    p.ln1b = (const float*)d_in[12]; p.w_up = (const float*)d_in[13]; p.conv_w = (const float*)d_in[14]; p.conv_b = (const float*)d_in[15]; p.w_down = (const float*)d_in[16]; p.ln2g = (const float*)d_in[17];
    p.ln2b = (const float*)d_in[18]; p.out = (float*)d_out; p.ws = (unsigned char*)d_ws;
    if (hipMemsetAsync((unsigned char*)d_ws + OFF_BAR, 0, XCD_BAR_WORDS * 4, stream) != hipSuccess) { fprintf(stderr, "kernel_launch: memset of barrier words failed\n"); return; }
    void* args[] = {&p};
    hipError_t e = hipLaunchCooperativeKernel((const void*)mega, dim3(NWG), dim3(NTH), args, LDS_BYTES, stream);
    if (e != hipSuccess) fprintf(stderr, "kernel_launch: cooperative launch failed: %s\n", hipGetErrorString(e));
}
```

```cpp
#include <hip/hip_runtime.h>
#include <hip/hip_cooperative_groups.h>
#include <cstdio>
namespace cg = cooperative_groups;

#define LAS __attribute__((address_space(3)))
typedef unsigned short bf16_t;
typedef short bf16x8 __attribute__((ext_vector_type(8)));
typedef short bf16x4 __attribute__((ext_vector_type(4)));
typedef float f32x4 __attribute__((ext_vector_type(4)));
typedef float f32x2 __attribute__((ext_vector_type(2)));
typedef float f32x16 __attribute__((ext_vector_type(16)));
typedef unsigned u32x4 __attribute__((ext_vector_type(4)));
typedef unsigned u32x2 __attribute__((ext_vector_type(2)));
typedef _Float16 f16x4 __attribute__((ext_vector_type(4)));

constexpr int T_TOK = 32768, DM = 1024, SEQ = 8192, NPJ = 5760  , DFF = 2816;
constexpr int HB = 1024, H_Q = 0, H_K = 128, H_V = 256, H_WA = 512, H_GB = 768, C_QB = 4096, C_KB = 5120, C_VB = 5248, C_LR = 5376;
constexpr float ALPHA = 1.189207115002721f, LOG2E = 1.4426950408889634f;
constexpr int NWG = 256, NTH = 512;
constexpr int LDS_CW = 131072 + 512;
constexpr int LDS_BYTES = 155648;
constexpr size_t OFF_WIN = 0, OFF_WO = 13631488, OFF_WUP = 15728640, OFF_WDN = 27262976, OFF_MODP = 33030144, OFF_MODF = 34603008,
                 OFF_ROPE = 34701312, OFF_DEC = 36798464, OFF_DSUP = 37847040, OFF_BAR = 37978112, OFF_PROJ = 38797312;
constexpr size_t PROJ_BYTES = (size_t)T_TOK * NPJ * 2;
constexpr size_t OFF_H2 = OFF_PROJ + (1u << 20), OFF_F = OFF_PROJ + (80u << 20), OFF_X1 = OFF_PROJ + (256u << 20), OFF_ACC1 = OFF_PROJ + (363u << 20), OFF_HT = OFF_PROJ + (428u << 20);
constexpr size_t WS_NEED = OFF_PROJ + (451u << 20);
constexpr size_t OO_H = 0, OO_KOT = 0, OO_ABUF = (32u << 20), OO_USUP = (48u << 20), OO_ACC1 = 0;

struct Params {
    const float* x; const float* c; const int* pos; const float* w_ada; const float* b_ada; const float* w_in; const float* w_lr; const float* b_lr;
    const float* gnorm; const float* sinks; const float* w_o; const float* ln1g; const float* ln1b; const float* w_up; const float* conv_w; const float* conv_b;
    const float* w_down; const float* ln2g; const float* ln2b; float* out; unsigned char* ws;
};

__device__ __forceinline__ float bf2f(bf16_t b) { return __uint_as_float(((unsigned)b) << 16); }
__device__ __forceinline__ unsigned cvt_pk(float lo, float hi) { unsigned r; asm("v_cvt_pk_bf16_f32 %0, %1, %2" : "=v"(r) : "v"(lo), "v"(hi)); return r; }
__device__ __forceinline__ bf16_t f2bf(float f) { return (bf16_t)(cvt_pk(f, 0.f) & 0xFFFFu); }
__device__ __forceinline__ f32x4 bf4_to_f32(u32x2 v) { f32x4 r; r[0] = __uint_as_float(v[0] << 16); r[1] = __uint_as_float(v[0] & 0xFFFF0000u); r[2] = __uint_as_float(v[1] << 16); r[3] = __uint_as_float(v[1] & 0xFFFF0000u); return r; }
__device__ __forceinline__ float wave_sum(float v) {
#pragma unroll
    for (int o = 32; o; o >>= 1) v += __shfl_xor(v, o);
    return v; }
__device__ __forceinline__ int tid_opaque() { int t = threadIdx.x; asm volatile("" : "+v"(t)); return t; }
__device__ __forceinline__ float sigmoidf_(float v) { return __builtin_amdgcn_rcpf(1.f + __expf(-v)); }
__device__ __forceinline__ void lds_barrier() { asm volatile("s_waitcnt lgkmcnt(0)\n\ts_barrier" ::: "memory"); }


#define XB_TMO      128
#define XB_XCNT(j)  (256  + 64 * (j))
#define XB_XSUB(j)  (1280 + 64 * (j))
#define XB_XGEN(j)  (2304 + 64 * (j))
#define XB_TOP      3328
#define XB_TOPGEN   3392
#define XCD_BAR_WORDS 3456
#define XB_SPIN_CAP (1u << 22)
__device__ __forceinline__ unsigned xb_ld(unsigned* p)              { return __hip_atomic_load(p, __ATOMIC_RELAXED, __HIP_MEMORY_SCOPE_AGENT); }
__device__ __forceinline__ unsigned xb_add(unsigned* p, unsigned v) { return __hip_atomic_fetch_add(p, v, __ATOMIC_RELAXED, __HIP_MEMORY_SCOPE_AGENT); }
__device__ __forceinline__ unsigned xb_xcc_id() { return (unsigned)__builtin_amdgcn_s_getreg((3 << 11) | 20) & 0xFu; }
#define XB_SPIN(cond, bar) do { unsigned _sp = 0; while (cond) { __builtin_amdgcn_s_sleep(1); \
    if ((++_sp & 255u) == 0u) { if (xb_ld(&(bar)[XB_TMO])) break; if (_sp > XB_SPIN_CAP) { atomicAdd(&(bar)[XB_TMO], 1u); break; } } } } while (0)
struct XcdBarrier { unsigned* bar; unsigned x; volatile LAS unsigned* st; };
__device__ __forceinline__ XcdBarrier xcd_barrier_post(unsigned* bar, volatile LAS unsigned* st) {
    XcdBarrier b; b.bar = bar; b.x = xb_xcc_id(); b.st = st;
    if (threadIdx.x == 0) (void)xb_add(&bar[XB_XCNT(b.x)], 1u);
    return b;
}
__device__ __forceinline__ void xcd_barrier_complete(unsigned* bar, unsigned x, unsigned& nloc, unsigned& nx) {
    const unsigned G = gridDim.x * gridDim.y * gridDim.z;
    unsigned sum, cnt, mine, sp = 0u;
    for (;;) {
        sum = 0u; cnt = 0u; mine = 0u;
#pragma unroll
        for (unsigned j = 0; j < 16; ++j) { const unsigned c = xb_ld(&bar[XB_XCNT(j)]); sum += c; cnt += (c > 0u) ? 1u : 0u; mine = (j == x) ? c : mine; }
        if (sum == G) break;
        __builtin_amdgcn_s_sleep(1);
        if ((++sp & 255u) == 0u) { if (xb_ld(&bar[XB_TMO])) break; if (sp > XB_SPIN_CAP) { atomicAdd(&bar[XB_TMO], 1u); break; } }
    }
    nloc = mine > 0u ? mine : 1u; nx = cnt > 0u ? cnt : 1u;
}
__device__ __forceinline__ void xcd_barrier(const XcdBarrier& b) {
    asm volatile("s_waitcnt vmcnt(0)" ::: "memory");
    __syncthreads();
    if (threadIdx.x == 0) {
        unsigned* bar = b.bar;
        __builtin_amdgcn_s_waitcnt(0);
        unsigned nloc = b.st[0], nx = b.st[1];
        if (nloc == 0u) { xcd_barrier_complete(bar, b.x, nloc, nx); b.st[0] = nloc; b.st[1] = nx; }
        const unsigned old = xb_add(&bar[XB_XSUB(b.x)], 1u);
        const unsigned gen = old / nloc;
        if (old + 1u == (gen + 1u) * nloc) {
            __builtin_amdgcn_fence(__ATOMIC_RELEASE, "agent");
            asm volatile("s_waitcnt vmcnt(0)" ::: "memory");
            const unsigned og = xb_add(&bar[XB_TOP], 1u);
            const unsigned tg = og / nx;
            if (og + 1u == (tg + 1u) * nx) xb_add(&bar[XB_TOPGEN], 1u);
            else XB_SPIN(xb_ld(&bar[XB_TOPGEN]) == tg, bar);
            __builtin_amdgcn_fence(__ATOMIC_ACQUIRE, "agent");
            xb_add(&bar[XB_XGEN(b.x)], 1u);
            asm volatile("s_waitcnt vmcnt(0)" ::: "memory");
        } else {
            XB_SPIN(xb_ld(&bar[XB_XGEN(b.x)]) == gen, bar);
            __builtin_amdgcn_fence(__ATOMIC_ACQUIRE, "agent");
            asm volatile("s_waitcnt vmcnt(0)" ::: "memory");
        }
    }
    __syncthreads();
}

namespace pg8 {
constexpr int BM = 256, BK = 64, HALF = 128, HTB = HALF * BK * 2, NXCD = 8, WGM = 8;
__device__ __forceinline__ int lds_byte(int r, int c) { const int st = (r >> 4) * 2 + (c >> 5), rr = r & 15, cc = c & 31, ob = rr * 64 + cc * 2; return st * 1024 + (ob ^ (((ob >> 9) & 1) << 5)); }
__device__ __forceinline__ void stage_rc(int b, int& R, int& C) { const int st = b / 1024, sb = b % 1024, swz = sb ^ (((sb >> 9) & 1) << 5); R = (st >> 1) * 16 + swz / 64; C = (st & 1) * 32 + (swz % 64) / 2; }
__device__ __forceinline__ int perm32(int rho) { const int n = rho >> 4, i = rho & 15; return 8 * (i >> 2) + 4 * n + (i & 3); }
struct Unit { int pm, pn; };
struct Gemm { const bf16_t* A; const bf16_t* Bt; int nM, nN, K, lda, grp; };
struct StaticOrder {
    int nM, nN, nwg, G, c;
    __device__ void init(int nM_, int nN_, int G_, int c_) { nM = nM_; nN = nN_; nwg = nM * nN; G = G_; c = c_; }
    __device__ bool next(int i, Unit& u) const {
        const long L = (long)i * G + c; if (L >= nwg) return false;
        int wgid = (int)L; { const int q = nwg / NXCD, r = nwg % NXCD, xcd = wgid % NXCD, off = wgid / NXCD; wgid = (xcd < r ? xcd * (q + 1) : r * (q + 1) + (xcd - r) * q) + off; }
        const int nig = WGM * nN, gid = wgid / nig, fm = gid * WGM, gsz = (nM - fm) < WGM ? (nM - fm) : WGM;
        u.pm = fm + ((wgid % nig) % gsz); u.pn = (wgid % nig) / gsz; return true;
    }
};

#ifndef PG8_SP2
#define PG8_SP2 true
#endif
#ifndef PG8_ALIGN
#define PG8_ALIGN true
#endif
template <class Epi, bool ALIGN_EPI = PG8_ALIGN, bool SP2 = PG8_SP2>
__device__ __forceinline__ void gemm_phase(LAS unsigned char* lds, const Gemm g, const StaticOrder& S, const Epi& E) {
    int tid = threadIdx.x; asm volatile("" : "+v"(tid));
    const int wid = __builtin_amdgcn_readfirstlane(tid >> 6), lane = tid & 63, wr = wid >> 2, wc = wid & 3, fr = lane & 15, fq = lane >> 4;
    const int K = g.K, nt = K / BK;
    unsigned voffA[2], voffB[2];
#pragma unroll
    for (int i = 0; i < 2; ++i) { int R, C; stage_rc(tid * 16 + i * 8192, R, C); const int Rb = Epi::PERM ? ((R & ~31) + perm32(R & 31)) : R;
        voffA[i] = (unsigned)(((R >> 6) * g.grp + (R & 63)) * g.lda + C) * 2u; voffB[i] = (unsigned)(Rb * K + C) * 2u; }
    const size_t kstep = (size_t)(BK * 2);
    const size_t hstepA = (size_t)2 * g.grp * g.lda * 2, tstepA = 2 * hstepA;
    const size_t hstepB = (size_t)HALF * K * 2, tstepB = 2 * hstepB;
    const unsigned ldsw = (unsigned)wid * 1024u;
    const int aoff = lds_byte(wr * 64 + fr, fq * 8), boff = lds_byte(wc * 32 + fr, fq * 8);
#define PG8_SA(b, h) (((b) * 2 + (h)) * HTB)
#define PG8_SB(b, h) ((4 + (b) * 2 + (h)) * HTB)
#define PG8_STAGE(bufoff, gbase, voff) do { _Pragma("unroll") for (int _i = 0; _i < 2; ++_i) \
        __builtin_amdgcn_global_load_lds((const unsigned*)((const char*)(gbase) + (voff)[_i]), (LAS unsigned*)(lds + (bufoff) + ldsw + _i * 8192), 16, 0, 0); } while (0)
#define PG8_LDA(dst, b, h) do { _Pragma("unroll") for (int m = 0; m < 4; ++m) _Pragma("unroll") for (int k = 0; k < 2; ++k) dst[m][k] = *(const LAS bf16x8*)(lds + PG8_SA(b, h) + aoff + m * 2048 + k * 1024); } while (0)
#define PG8_LDB(dst, b, h) do { _Pragma("unroll") for (int n = 0; n < 2; ++n) _Pragma("unroll") for (int k = 0; k < 2; ++k) dst[n][k] = *(const LAS bf16x8*)(lds + PG8_SB(b, h) + boff + n * 2048 + k * 1024); } while (0)
#define PG8_MMA(ai, bj, At, Bt) do { __builtin_amdgcn_s_setprio(1); _Pragma("unroll") for (int m = 0; m < 4; ++m) _Pragma("unroll") for (int n = 0; n < 2; ++n) _Pragma("unroll") for (int k = 0; k < 2; ++k) \
        acc[ai][bj][m][n] = __builtin_amdgcn_mfma_f32_16x16x32_bf16(Bt[n][k], At[m][k], acc[ai][bj][m][n], 0, 0, 0); __builtin_amdgcn_s_setprio(0); } while (0)
#define PG8_WAIT_V(n) asm volatile("s_waitcnt vmcnt(" #n ")" ::: "memory")
#define PG8_WAIT_L(n) asm volatile("s_waitcnt lgkmcnt(" #n ")" ::: "memory")
#define PG8_BAR __builtin_amdgcn_s_barrier()
#define PG8_SCHED __builtin_amdgcn_sched_barrier(0)
    Unit cur, nxt; int ui = 0;
    if (!S.next(0, cur)) return;
    E.prefetch(cur, lds, 0, wid, lane);
    f32x4 acc[2][2][4][2];
#pragma unroll
    for (int a = 0; a < 2; ++a)
#pragma unroll
        for (int b = 0; b < 2; ++b)
#pragma unroll
            for (int m = 0; m < 4; ++m)
#pragma unroll
                for (int n = 0; n < 2; ++n) acc[a][b][m][n] = (f32x4){0.f, 0.f, 0.f, 0.f};
    bf16x8 At[4][2], B0[2][2], B1[2][2];
    const char* cA = (const char*)g.A + (size_t)cur.pm * tstepA; const char* cB = (const char*)g.Bt + (size_t)cur.pn * tstepB;
    if constexpr (SP2) {
        PG8_STAGE(PG8_SB(0, 0), cB, voffB); PG8_STAGE(PG8_SB(0, 1), cB + hstepB, voffB); PG8_STAGE(PG8_SA(0, 0), cA, voffA); PG8_STAGE(PG8_SA(0, 1), cA + hstepA, voffA);
        if (wr == 1) PG8_BAR;
        PG8_WAIT_V(2); PG8_BAR;
        PG8_STAGE(PG8_SB(1, 0), cB + kstep, voffB); PG8_STAGE(PG8_SA(1, 0), cA + kstep, voffA); PG8_STAGE(PG8_SB(1, 1), cB + hstepB + kstep, voffB);
        PG8_WAIT_V(6); PG8_BAR;
    } else {
        PG8_STAGE(PG8_SB(0, 0), cB, voffB); PG8_STAGE(PG8_SA(0, 0), cA, voffA); PG8_STAGE(PG8_SB(0, 1), cB + hstepB, voffB); PG8_STAGE(PG8_SA(0, 1), cA + hstepA, voffA);
        if (wr == 1) PG8_BAR;
        PG8_WAIT_V(4); PG8_BAR;
        PG8_STAGE(PG8_SB(1, 0), cB + kstep, voffB); PG8_STAGE(PG8_SA(1, 0), cA + kstep, voffA); PG8_STAGE(PG8_SB(1, 1), cB + hstepB + kstep, voffB);
        PG8_WAIT_V(6); PG8_BAR;
    }
    for (;;) {
        const bool has_next = S.next(ui + 1, nxt);
        const char* nA = has_next ? (const char*)g.A + (size_t)nxt.pm * tstepA : cA; const char* nB = has_next ? (const char*)g.Bt + (size_t)nxt.pn * tstepB : cB;
        for (int t = 0; t < nt; t += 2) {
            const bool last = (t == nt - 2);
            const char* a1 = cA + (size_t)(t + 1) * kstep;
            const char* a2 = last ? nA : cA + (size_t)(t + 2) * kstep; const char* b2 = last ? nB : cB + (size_t)(t + 2) * kstep;
            const char* a3 = a2 + kstep; const char* b3 = b2 + kstep;
            if constexpr (SP2) {
            PG8_LDB(B0, 0, 0); PG8_LDB(B1, 0, 1); PG8_SCHED; PG8_LDA(At, 0, 0); PG8_STAGE(PG8_SA(1, 1), a1 + hstepA, voffA);
            PG8_WAIT_V(8); PG8_WAIT_L(0); PG8_BAR; PG8_MMA(0, 0, At, B0); PG8_MMA(0, 1, At, B1); PG8_BAR; PG8_SCHED;
            PG8_LDA(At, 0, 1); PG8_STAGE(PG8_SB(0, 0), b2, voffB); PG8_STAGE(PG8_SB(0, 1), b2 + hstepB, voffB); PG8_STAGE(PG8_SA(0, 0), a2, voffA);
            PG8_WAIT_V(8); PG8_WAIT_L(0); PG8_BAR; PG8_MMA(1, 0, At, B0); PG8_MMA(1, 1, At, B1); PG8_BAR; PG8_SCHED;
            PG8_LDB(B0, 1, 0); PG8_LDB(B1, 1, 1); PG8_SCHED; PG8_LDA(At, 1, 0); PG8_STAGE(PG8_SA(0, 1), a2 + hstepA, voffA);
            PG8_WAIT_V(8); PG8_WAIT_L(0); PG8_BAR; PG8_MMA(0, 0, At, B0); PG8_MMA(0, 1, At, B1); PG8_BAR; PG8_SCHED;
            PG8_LDA(At, 1, 1); PG8_STAGE(PG8_SB(1, 0), b3, voffB); PG8_STAGE(PG8_SB(1, 1), b3 + hstepB, voffB); PG8_STAGE(PG8_SA(1, 0), a3, voffA);
            PG8_WAIT_V(8); PG8_WAIT_L(0); PG8_BAR; PG8_MMA(1, 0, At, B0); PG8_MMA(1, 1, At, B1); PG8_BAR; PG8_SCHED;
            } else {
            PG8_LDB(B0, 0, 0); PG8_SCHED; PG8_LDA(At, 0, 0); PG8_STAGE(PG8_SA(1, 1), a1 + hstepA, voffA);
            PG8_WAIT_L(8); PG8_BAR; PG8_WAIT_L(0); PG8_MMA(0, 0, At, B0); PG8_BAR; PG8_SCHED;
            PG8_LDB(B1, 0, 1); PG8_STAGE(PG8_SB(0, 0), b2, voffB);
            PG8_BAR; PG8_WAIT_L(0); PG8_MMA(0, 1, At, B1); PG8_BAR;
            PG8_LDA(At, 0, 1); PG8_STAGE(PG8_SA(0, 0), a2, voffA);
            PG8_BAR; PG8_WAIT_L(0); PG8_MMA(1, 0, At, B0); PG8_BAR; PG8_SCHED;
            PG8_STAGE(PG8_SB(0, 1), b2 + hstepB, voffB);
            PG8_WAIT_V(6); PG8_BAR; PG8_MMA(1, 1, At, B1); PG8_BAR;
            PG8_LDB(B0, 1, 0); PG8_SCHED; PG8_LDA(At, 1, 0); PG8_STAGE(PG8_SA(0, 1), a2 + hstepA, voffA);
            PG8_WAIT_L(8); PG8_BAR; PG8_WAIT_L(0); PG8_MMA(0, 0, At, B0); PG8_BAR; PG8_SCHED;
            PG8_LDB(B1, 1, 1); PG8_STAGE(PG8_SB(1, 0), b3, voffB);
            PG8_BAR; PG8_WAIT_L(0); PG8_MMA(0, 1, At, B1); PG8_BAR;
            PG8_LDA(At, 1, 1); PG8_STAGE(PG8_SA(1, 0), a3, voffA);
            PG8_BAR; PG8_WAIT_L(0); PG8_MMA(1, 0, At, B0); PG8_BAR; PG8_SCHED;
            PG8_STAGE(PG8_SB(1, 1), b3 + hstepB, voffB);
            PG8_WAIT_V(6); PG8_BAR; PG8_MMA(1, 1, At, B1); PG8_BAR;
            }
        }
        if constexpr (ALIGN_EPI) { if (wr == 0) PG8_BAR; }
        E(acc, cur, wr, wc, fr, fq, lds, ui & 1);
        if (!has_next) break;
#pragma unroll
        for (int a = 0; a < 2; ++a)
#pragma unroll
            for (int b = 0; b < 2; ++b)
#pragma unroll
                for (int m = 0; m < 4; ++m)
#pragma unroll
                    for (int n = 0; n < 2; ++n) acc[a][b][m][n] = (f32x4){0.f, 0.f, 0.f, 0.f};
        cur = nxt; cA = nA; cB = nB; ++ui;
        E.prefetch(cur, lds, ui & 1, wid, lane);
        if constexpr (ALIGN_EPI) { if (wr == 1) PG8_BAR; }
    }
    PG8_WAIT_V(0);
    if constexpr (!ALIGN_EPI) { if (wr == 0) PG8_BAR; }
    PG8_BAR;
#undef PG8_SA
#undef PG8_SB
#undef PG8_STAGE
#undef PG8_LDA
#undef PG8_LDB
#undef PG8_MMA
#undef PG8_WAIT_V
#undef PG8_WAIT_L
#undef PG8_BAR
#undef PG8_SCHED
}
}

__device__ __forceinline__ float gelu_f(float v) {
    const float av = fabsf(v), t = __builtin_amdgcn_rcpf(av * 0.2316418882f + 1.0f);
    float q = t * 0.5307027145f + (-0.7265760135f); q = q * t + 0.7107068705f; q = q * t + (-0.142248368f); q = q * t + 0.127414796f; q = q * t;
    const float e = __builtin_amdgcn_exp2f((v * v) * (-0.72134752044f));
    const float m = v * (q * e);
    return fmaxf(v, 0.f) - fabsf(m);
}

__device__ __forceinline__ f32x2 gelu_pk(f32x2 v) {
    const f32x2 av = __builtin_elementwise_abs(v), d = av * 0.2316418882f + 1.0f;
    f32x2 t; t.x = __builtin_amdgcn_rcpf(d.x); t.y = __builtin_amdgcn_rcpf(d.y);
    f32x2 q = t * 0.5307027145f + (-0.7265760135f); q = q * t + 0.7107068705f; q = q * t + (-0.142248368f); q = q * t + 0.127414796f; q = q * t;
    const f32x2 s = (v * v) * (-0.72134752044f);
    f32x2 e; e.x = __builtin_amdgcn_exp2f(s.x); e.y = __builtin_amdgcn_exp2f(s.y);
    const f32x2 m = v * (q * e);
    f32x2 o; o.x = fmaxf(v.x, 0.f) - fabsf(m.x); o.y = fmaxf(v.y, 0.f) - fabsf(m.y); return o;
}

struct EpiProj {
    static constexpr bool PERM = true;
    bf16_t* O; int ld;
    __device__ __forceinline__ void prefetch(const pg8::Unit&, LAS unsigned char*, int, int, int) const {}
    __device__ __forceinline__ void operator()(const f32x4 (&acc)[2][2][4][2], const pg8::Unit& u, int wr, int wc, int fr, int fq, LAS unsigned char*, int) const {
        const int row0 = u.pm * 256 + wr * 64 + fr, col0 = u.pn * 256 + wc * 32 + 8 * fq;
#pragma unroll
        for (int ai = 0; ai < 2; ++ai)
#pragma unroll
            for (int m = 0; m < 4; ++m) { bf16_t* rowp = O + (size_t)(row0 + ai * 128 + m * 16) * ld + col0;
#pragma unroll
                for (int bj = 0; bj < 2; ++bj) { const f32x4 v0 = acc[ai][bj][m][0], v1 = acc[ai][bj][m][1];
                    u32x4 o; o[0] = cvt_pk(v0[0], v0[1]); o[1] = cvt_pk(v0[2], v0[3]); o[2] = cvt_pk(v1[0], v1[1]); o[3] = cvt_pk(v1[2], v1[3]);
                    *(u32x4*)(rowp + bj * 128) = o; } }
    }
};
struct EpiProjIn {
    static constexpr bool PERM = true;
    bf16_t* O;
    __device__ __forceinline__ void prefetch(const pg8::Unit&, LAS unsigned char*, int, int, int) const {}
    __device__ __forceinline__ void operator()(const f32x4 (&acc)[2][2][4][2], const pg8::Unit& u, int wr, int wc, int fr, int fq, LAS unsigned char*, int) const {
        const int row0 = u.pm * 256 + wr * 64 + fr;
        int cb; bool pair = false;
        if (u.pn < 20) { const int h = u.pn / 5, t = u.pn - 5 * h; pair = (t == 2) || (t == 3); cb = h * HB + ((t == 0) ? 0 : (t == 1) ? H_V : (t == 2) ? H_WA : (t == 3) ? (H_WA + 128) : H_GB); }
        else cb = (u.pn < 24) ? (C_QB + (u.pn - 20) * 256) : (u.pn == 24) ? C_KB : C_LR;
        const int col0 = cb + wc * 32 + 8 * fq;
        if (pair) {
#pragma unroll
            for (int ai = 0; ai < 2; ++ai)
#pragma unroll
                for (int m = 0; m < 4; ++m) { float wv[8];
#pragma unroll
                    for (int j2 = 0; j2 < 4; ++j2) {
                        const f32x2 r = {acc[ai][0][m][j2 >> 1][2 * (j2 & 1)], acc[ai][0][m][j2 >> 1][2 * (j2 & 1) + 1]}, g = {acc[ai][1][m][j2 >> 1][2 * (j2 & 1)], acc[ai][1][m][j2 >> 1][2 * (j2 & 1) + 1]};
                        const f32x2 xr = r * (-LOG2E), xg = g * (-LOG2E);
                        f32x2 er, eg; er.x = __builtin_amdgcn_exp2f(xr.x); er.y = __builtin_amdgcn_exp2f(xr.y); eg.x = __builtin_amdgcn_exp2f(xg.x); eg.y = __builtin_amdgcn_exp2f(xg.y);
                        const f32x2 den = (er + 1.0f) * (eg + 1.0f);
                        f32x2 rc; rc.x = __builtin_amdgcn_rcpf(den.x); rc.y = __builtin_amdgcn_rcpf(den.y);
                        const f32x2 w = r * rc; wv[2 * j2] = w.x; wv[2 * j2 + 1] = w.y; }
                    u32x4 o; o[0] = cvt_pk(wv[0], wv[1]); o[1] = cvt_pk(wv[2], wv[3]); o[2] = cvt_pk(wv[4], wv[5]); o[3] = cvt_pk(wv[6], wv[7]);
                    *(u32x4*)(O + (size_t)(row0 + ai * 128 + m * 16) * NPJ + col0) = o; }
        } else {
            if (u.pn == 25 && (wc != 0 || fq >= 2)) return;
            const int nbj = (u.pn == 25) ? 1 : 2;
#pragma unroll
            for (int ai = 0; ai < 2; ++ai)
#pragma unroll
                for (int m = 0; m < 4; ++m) { bf16_t* rowp = O + (size_t)(row0 + ai * 128 + m * 16) * NPJ + col0;
#pragma unroll
                    for (int bj = 0; bj < 2; ++bj) { if (bj >= nbj) continue; const f32x4 v0 = acc[ai][bj][m][0], v1 = acc[ai][bj][m][1];
                        u32x4 o; o[0] = cvt_pk(v0[0], v0[1]); o[1] = cvt_pk(v0[2], v0[3]); o[2] = cvt_pk(v1[0], v1[1]); o[3] = cvt_pk(v1[2], v1[3]);
                        *(u32x4*)(rowp + bj * 128) = o; } }
        }
    }
};
struct EpiUp {
    static constexpr bool PERM = true;
    bf16_t* F; const float* cw; const float* cb; bf16_t* HT;
    __device__ __forceinline__ void prefetch(const pg8::Unit& u, LAS unsigned char* lds, int par, int wid, int lane) const {
        if (wid < 4) { const int li = wid * 64 + lane, row = li >> 5, ch = u.pn * 128 + (li & 31) * 4;
            const float* src = ((row & 3) == 3) ? (cb + (row >> 2) * DFF + ch) : (cw + (row & 3) * 2 * DFF + (row >> 2) * DFF + ch);
            __builtin_amdgcn_global_load_lds((const unsigned*)src, (LAS unsigned*)(lds + LDS_CW + par * 4096 + wid * 1024), 16, 0, 0); }
    }
    __device__ __forceinline__ void operator()(const f32x4 (&acc)[2][2][4][2], const pg8::Unit& u, int wr, int wc, int fr, int fq, LAS unsigned char* lds, int par) const {
        const int ch0 = u.pn * 128 + wc * 32 + 8 * fq;
        u32x2 pk0[2][4];
#pragma unroll
        for (int n = 0; n < 2; ++n) {
            const LAS float* wl = (const LAS float*)(lds + LDS_CW + par * 4096) + wc * 32 + 8 * fq + 4 * n;
            const f32x4 wg0 = *(const LAS f32x4*)(wl), wg1 = *(const LAS f32x4*)(wl + 128), wg2 = *(const LAS f32x4*)(wl + 256), bg = *(const LAS f32x4*)(wl + 384);
            const f32x4 wv0 = *(const LAS f32x4*)(wl + 512), wv1 = *(const LAS f32x4*)(wl + 640), wv2 = *(const LAS f32x4*)(wl + 768), bv = *(const LAS f32x4*)(wl + 896);
#pragma unroll
            for (int ai = 0; ai < 2; ++ai) {
                const int grp = 4 * u.pm + 2 * ai + wr, tg0 = grp * 64;
#pragma unroll
                for (int m = 0; m < 4; ++m) {
                    const int tk = tg0 + 16 * m + fr;
                    float fo[4];
#pragma unroll
                    for (int e2 = 0; e2 < 2; ++e2) {
                        f32x2 r[2];
#pragma unroll
                        for (int bj = 0; bj < 2; ++bj) {
                            f32x2 cur, p1, p2;
#pragma unroll
                            for (int q = 0; q < 2; ++q) { const int e = 2 * e2 + q; const float c = acc[ai][bj][m][n][e]; cur[q] = c;
                                float t1 = c, t2 = c;
                                if (m > 0) { const float prv = acc[ai][bj][m > 0 ? m - 1 : 0][n][e]; t1 = (fr == 15) ? prv : c; t2 = (fr >= 14) ? prv : c; }
                                const int i1 = __builtin_bit_cast(int, t1), i2 = __builtin_bit_cast(int, t2);
                                p1[q] = __builtin_bit_cast(float, __builtin_amdgcn_update_dpp(i1, i1, 0x121, 0xF, 0xF, true));
                                p2[q] = __builtin_bit_cast(float, __builtin_amdgcn_update_dpp(i2, i2, 0x122, 0xF, 0xF, true)); }
                            const f32x4 W0 = bj ? wv0 : wg0, W1 = bj ? wv1 : wg1, W2 = bj ? wv2 : wg2, BB = bj ? bv : bg;
                            const f32x2 w0 = {W0[2 * e2], W0[2 * e2 + 1]}, w1 = {W1[2 * e2], W1[2 * e2 + 1]}, w2 = {W2[2 * e2], W2[2 * e2 + 1]}, bb = {BB[2 * e2], BB[2 * e2 + 1]};
                            r[bj] = bb + w0 * p2 + w1 * p1 + w2 * cur;
                        }
                        { const f32x2 ff = gelu_pk(r[0]) * r[1]; fo[2 * e2] = ff[0]; fo[2 * e2 + 1] = ff[1]; }
                    }
                    u32x2 o; o[0] = cvt_pk(fo[0], fo[1]); o[1] = cvt_pk(fo[2], fo[3]);
                    if (n == 0) pk0[ai][m] = o;
                    else {
                        if (m > 0 || fr >= 2) { u32x4 o4; o4[0] = pk0[ai][m][0]; o4[1] = pk0[ai][m][1]; o4[2] = o[0]; o4[3] = o[1]; *(u32x4*)(F + (size_t)tk * DFF + ch0) = o4; }
                        if ((m == 0 && fr < 2) || (m == 3 && fr >= 14)) {
                            bf16_t* hp = HT + ((size_t)grp * 4 + ((m == 0) ? fr : (fr - 12))) * (2 * DFF) + ch0;
                            u32x4 og, ov;
#pragma unroll
                            for (int nn = 0; nn < 2; ++nn) { og[2 * nn] = cvt_pk(acc[ai][0][m][nn][0], acc[ai][0][m][nn][1]); og[2 * nn + 1] = cvt_pk(acc[ai][0][m][nn][2], acc[ai][0][m][nn][3]);
                                ov[2 * nn] = cvt_pk(acc[ai][1][m][nn][0], acc[ai][1][m][nn][1]); ov[2 * nn + 1] = cvt_pk(acc[ai][1][m][nn][2], acc[ai][1][m][nn][3]); }
                            *(u32x4*)hp = og; *(u32x4*)(hp + DFF) = ov; } }
                }
            }
        }
    }
};
__device__ void conv_seams(const Params& p) {
    const bf16_t* __restrict__ HT = (const bf16_t*)(p.ws + OFF_HT); bf16_t* __restrict__ F = (bf16_t*)(p.ws + OFF_F);
    const float* __restrict__ cw = p.conv_w; const float* __restrict__ cb = p.conv_b;
    for (int it = blockIdx.x * NTH + tid_opaque(); it < 512 * 704; it += NWG * NTH) {
        const int c4 = it % 704, g = it / 704, ch = 4 * c4; const bool first = ((g * 64) & (SEQ - 1)) == 0;
        f32x4 w0[2], w1[2], w2[2], bb[2], h0[2], h1[2], t0[2], t1[2];
#pragma unroll
        for (int bj = 0; bj < 2; ++bj) { const int cc = bj * DFF + ch;
            w0[bj] = *(const f32x4*)(cw + cc); w1[bj] = *(const f32x4*)(cw + 2 * DFF + cc); w2[bj] = *(const f32x4*)(cw + 4 * DFF + cc); bb[bj] = *(const f32x4*)(cb + cc);
            h0[bj] = bf4_to_f32(*(const u32x2*)(HT + ((size_t)g * 4 + 0) * (2 * DFF) + cc)); h1[bj] = bf4_to_f32(*(const u32x2*)(HT + ((size_t)g * 4 + 1) * (2 * DFF) + cc));
            t0[bj] = (f32x4){0.f, 0.f, 0.f, 0.f}; t1[bj] = (f32x4){0.f, 0.f, 0.f, 0.f};
            if (!first) { t0[bj] = bf4_to_f32(*(const u32x2*)(HT + ((size_t)(g - 1) * 4 + 2) * (2 * DFF) + cc)); t1[bj] = bf4_to_f32(*(const u32x2*)(HT + ((size_t)(g - 1) * 4 + 3) * (2 * DFF) + cc)); } }
        f32x4 u0[2], u1[2];
#pragma unroll
        for (int bj = 0; bj < 2; ++bj) { u0[bj] = bb[bj] + w0[bj] * t0[bj] + w1[bj] * t1[bj] + w2[bj] * h0[bj]; u1[bj] = bb[bj] + w0[bj] * t1[bj] + w1[bj] * h0[bj] + w2[bj] * h1[bj]; }
        u32x2 o; o[0] = cvt_pk(gelu_f(u0[0][0]) * u0[1][0], gelu_f(u0[0][1]) * u0[1][1]); o[1] = cvt_pk(gelu_f(u0[0][2]) * u0[1][2], gelu_f(u0[0][3]) * u0[1][3]);
        *(u32x2*)(F + (size_t)(g * 64) * DFF + ch) = o;
        o[0] = cvt_pk(gelu_f(u1[0][0]) * u1[1][0], gelu_f(u1[0][1]) * u1[1][1]); o[1] = cvt_pk(gelu_f(u1[0][2]) * u1[1][2], gelu_f(u1[0][3]) * u1[1][3]);
        *(u32x2*)(F + (size_t)(g * 64 + 1) * DFF + ch) = o;
    }
}

__device__ __forceinline__ int colmap(int mat, int n) {
    if (mat == 0) {
        if (n < 5120) { const int h = n / 1280, w = n - h * 1280, t = w >> 8, x = w & 255;
            if (t == 0) return (x < 128) ? (h * 128 + x) : (512 + h * 128 + (x - 128));
            if (t == 1) return 1024 + h * 256 + x;
            if (t == 2) return (x < 128) ? (2048 + h * 256 + x) : (4368 + h * 256 + (x - 128));
            if (t == 3) return (x < 128) ? (2048 + h * 256 + 128 + x) : (4368 + h * 256 + 128 + (x - 128));
            return 5392 + h * 256 + x; }
        if (n < 6144) return 3088 + (n - 5120); if (n < 6400) return 4112 + (n - 6144); if (n < 6416) return 3072 + (n - 6400); return -1; }
    if (mat == 2) { const int pn = n >> 8, w = n & 255; return (w < 128) ? (pn * 128 + w) : (DFF + pn * 128 + (w - 128)); }
    return n;
}
struct P0Tile { int mat; const float* W; int ldw; bf16_t* dst; int Kd, k0, n0; };
__device__ __forceinline__ P0Tile p0_desc(const Params& p, int id) {
    bf16_t* win = (bf16_t*)(p.ws + OFF_WIN); bf16_t* wo = (bf16_t*)(p.ws + OFF_WO); bf16_t* wup = (bf16_t*)(p.ws + OFF_WUP); bf16_t* wdn = (bf16_t*)(p.ws + OFF_WDN);
    if (id < 1664) return P0Tile{0, p.w_in, 6416, win, 1024, (id & 15) * 64, (id >> 4) * 64};
    if (id < 1920) { const int j = id - 1664; return P0Tile{1, p.w_o, 1024, wo, 1024, (j & 15) * 64, (j >> 4) * 64}; }
    if (id < 3328) { const int j = id - 1920; return P0Tile{2, p.w_up, 2 * DFF, wup, 1024, (j & 15) * 64, (j >> 4) * 64}; }
    const int j = id - 3328; return P0Tile{3, p.w_down, 1024, wdn, DFF, (j % 44) * 64, (j / 44) * 64};
}
__device__ __forceinline__ void p0_load(const P0Tile& t, f32x4 (&v)[2]) {
    const int tid = tid_opaque();
#pragma unroll
    for (int i = 0; i < 2; ++i) { const int idx = tid + 512 * i, kl = idx >> 4, n4 = (idx & 15) * 4; const int oc = colmap(t.mat, t.n0 + n4);
        v[i] = (f32x4){0.f, 0.f, 0.f, 0.f}; if (oc >= 0) v[i] = __builtin_nontemporal_load((const f32x4*)(t.W + (size_t)(t.k0 + kl) * t.ldw + oc));
        const float sc = (t.mat == 0 && t.n0 + n4 < 5120 && ((t.n0 + n4) % 1280) < 128) ? 0.08838834764831845f : 1.f; v[i] = v[i] * sc; }
}
__device__ void weight_tiles(const Params& p, LAS unsigned char* lds, int id0, int id1) {
    const int tid = tid_opaque(), w = blockIdx.x;
    if (id0 + w >= id1) return;
    f32x4 v[2]; P0Tile t = p0_desc(p, id0 + w); p0_load(t, v);
    int par = 0;
    __syncthreads();
    for (int id = id0 + w; id < id1; id += NWG, par ^= 1) {
        LAS float* sT = (LAS float*)lds + par * (64 * 65 + 16);
#pragma unroll
        for (int i = 0; i < 2; ++i) { const int idx = tid + 512 * i, kl = idx >> 4, n4 = (idx & 15) * 4;
            sT[kl * 65 + n4 + 0] = v[i][0]; sT[kl * 65 + n4 + 1] = v[i][1]; sT[kl * 65 + n4 + 2] = v[i][2]; sT[kl * 65 + n4 + 3] = v[i][3]; }
        const P0Tile tc = t;
        if (id + NWG < id1) { t = p0_desc(p, id + NWG); p0_load(t, v); }
        __syncthreads();
        const int nl = tid >> 3, kc = tid & 7; u32x4 pk;
#pragma unroll
        for (int e = 0; e < 4; ++e) pk[e] = cvt_pk(sT[(kc * 8 + 2 * e) * 65 + nl], sT[(kc * 8 + 2 * e + 1) * 65 + nl]);
        *(u32x4*)(tc.dst + (size_t)(tc.n0 + nl) * tc.Kd + tc.k0 + kc * 8) = pk;
    }
    __syncthreads();
}
__device__ void phase0(const Params& p, LAS unsigned char* lds) {
    LAS float* sT = (LAS float*)lds; const int tid = tid_opaque(), w = blockIdx.x;
    if (w < 192) { const int cbk = w % 12, ks = w / 12; LAS float* sc = sT;
        if (tid < 256) { const float cv = p.c[(tid >> 6) * DM + ks * 64 + (tid & 63)]; sc[tid] = cv / (1.f + __expf(-cv)); }
        __syncthreads();
        const int col = cbk * 512 + tid; float a0 = 0.f, a1 = 0.f, a2 = 0.f, a3 = 0.f;
#pragma unroll 32
        for (int kk = 0; kk < 64; ++kk) { const float wv = __builtin_nontemporal_load(p.w_ada + (size_t)(ks * 64 + kk) * 6144 + col); a0 += sc[kk] * wv; a1 += sc[64 + kk] * wv; a2 += sc[128 + kk] * wv; a3 += sc[192 + kk] * wv; }
        float* mp = (float*)(p.ws + OFF_MODP) + (size_t)ks * 4 * 6144 + col; mp[0] = a0; mp[6144] = a1; mp[2 * 6144] = a2; mp[3 * 6144] = a3;
        __syncthreads();
    }
    { const float invf[8] = {1.0f, 0.1939227432012558f, 0.03760603070259094f, 0.007292664609849453f, 0.0014142135623842478f, 0.00027424818836152554f, 5.318296098266728e-05f, 1.0313386155758053e-05f};
        float* rope = (float*)(p.ws + OFF_ROPE);
#pragma unroll
        for (int it = 0; it < 2; ++it) { const int idx = w * 512 + tid + it * 131072, t = idx >> 3, i = idx & 7;
            float fi = invf[0];
#pragma unroll
            for (int q = 1; q < 8; ++q) fi = (i == q) ? invf[q] : fi;
            const float ang = (float)p.pos[t] * fi;
            const double nrev = rint((double)ang * 0.15915494309189535); const float r = (float)fma(-nrev, 6.283185307179586, (double)ang);
            rope[t * 16 + i] = __cosf(r); rope[t * 16 + 8 + i] = __sinf(r); } }
}

__device__ void phase_ln_in(const Params& p, LAS unsigned char* lds) {
    LAS float* s_scale = (LAS float*)lds; LAS float* s_shift = s_scale + 1024;
    const int tid = tid_opaque(), w = blockIdx.x, lane = tid & 63, wid = tid >> 6, b = w >> 6;
    const float* modp = (const float*)(p.ws + OFF_MODP);
    f32x4 nx[4][4];
#pragma unroll
    for (int pr = 0; pr < 3; ++pr)
#pragma unroll
        for (int i = 0; i < 4; ++i) nx[pr][i] = __builtin_nontemporal_load((const f32x4*)(p.x + (size_t)(w * 128 + wid * 16 + pr) * DM + i * 256 + lane * 4));
    for (int cc = tid; cc < 1024; cc += 512) { float a = p.b_ada[1024 + cc], s = p.b_ada[cc];
        for (int ks = 0; ks < 16; ++ks) { a += modp[(size_t)(ks * 4 + b) * 6144 + 1024 + cc]; s += modp[(size_t)(ks * 4 + b) * 6144 + cc]; }
        s_scale[cc] = 1.f + a; s_shift[cc] = s; }
    { const int idx = w * 512 + tid; if (idx < 24576) { const int bb = idx / 6144, j = idx % 6144; float a = p.b_ada[j];
            for (int ks = 0; ks < 16; ++ks) a += modp[(size_t)(ks * 4 + bb) * 6144 + j];
            ((float*)(p.ws + OFF_MODF))[idx] = a; } }
    __syncthreads();
    bf16_t* H = (bf16_t*)((unsigned char*)p.out + OO_H);
#pragma unroll
    for (int rr = 0; rr < 16; ++rr) { const int row = w * 128 + wid * 16 + rr; f32x4 v[4];
        if (rr + 3 < 16) {
#pragma unroll
            for (int i = 0; i < 4; ++i) nx[(rr + 3) & 3][i] = __builtin_nontemporal_load((const f32x4*)(p.x + (size_t)(row + 3) * DM + i * 256 + lane * 4)); }
#pragma unroll
        for (int i = 0; i < 4; ++i) v[i] = nx[rr & 3][i];
        float s = 0.f;
#pragma unroll
        for (int i = 0; i < 4; ++i) s += v[i][0] + v[i][1] + v[i][2] + v[i][3];
        const float mu = wave_sum(s) * (1.f / 1024.f); float q = 0.f;
#pragma unroll
        for (int i = 0; i < 4; ++i) { v[i] = v[i] - mu; q += v[i][0] * v[i][0] + v[i][1] * v[i][1] + v[i][2] * v[i][2] + v[i][3] * v[i][3]; }
        const float rstd = rsqrtf(wave_sum(q) * (1.f / 1024.f) + 1e-5f);
#pragma unroll
        for (int i = 0; i < 4; ++i) { const int c0 = i * 256 + lane * 4; const f32x4 sc = *(const LAS f32x4*)(s_scale + c0), sh = *(const LAS f32x4*)(s_shift + c0);
            const f32x4 hv = v[i] * rstd * sc + sh; u32x2 o; o[0] = cvt_pk(hv[0], hv[1]); o[1] = cvt_pk(hv[2], hv[3]); *(u32x2*)(H + (size_t)row * DM + c0) = o; }
    }
}

__device__ void phase_ln_mid(const Params& p) {
    const int tid = tid_opaque(), w = blockIdx.x, lane = tid & 63, wid = tid >> 6, b = w >> 6;
    const float* modf = (const float*)(p.ws + OFF_MODF) + b * 6144;
    bf16_t* H2 = (bf16_t*)(p.ws + OFF_H2); _Float16* X1H = (_Float16*)(p.ws + OFF_X1); const bf16_t* ACC = (const bf16_t*)(p.ws + OFF_ACC1);
    f32x4 g1[4], b1[4], sc2[4], sh2[4], gt[4];
#pragma unroll
    for (int i = 0; i < 4; ++i) { const int c0 = i * 256 + lane * 4; g1[i] = *(const f32x4*)(p.ln1g + c0); b1[i] = *(const f32x4*)(p.ln1b + c0);
        sc2[i] = *(const f32x4*)(modf + 4 * 1024 + c0) + 1.f; sh2[i] = *(const f32x4*)(modf + 3 * 1024 + c0); gt[i] = *(const f32x4*)(modf + 2 * 1024 + c0); }
    const size_t r0 = (size_t)(w * 128 + wid * 16) * DM;
    f32x4 nx[4][4]; u32x2 na[4][4];
#pragma unroll
    for (int pr = 0; pr < 3; ++pr)
#pragma unroll
        for (int i = 0; i < 4; ++i) { nx[pr][i] = __builtin_nontemporal_load((const f32x4*)(p.x + r0 + pr * DM + i * 256 + lane * 4)); na[pr][i] = __builtin_nontemporal_load((const u32x2*)(ACC + r0 + pr * DM + i * 256 + lane * 4)); }
#pragma unroll
    for (int rr = 0; rr < 16; ++rr) { const size_t ro = r0 + (size_t)rr * DM; f32x4 v[4];
        if (rr + 3 < 16) {
#pragma unroll
            for (int i = 0; i < 4; ++i) { nx[(rr + 3) & 3][i] = __builtin_nontemporal_load((const f32x4*)(p.x + ro + 3 * DM + i * 256 + lane * 4)); na[(rr + 3) & 3][i] = __builtin_nontemporal_load((const u32x2*)(ACC + ro + 3 * DM + i * 256 + lane * 4)); } }
#pragma unroll
        for (int i = 0; i < 4; ++i) v[i] = nx[rr & 3][i] * ALPHA + gt[i] * bf4_to_f32(na[rr & 3][i]);
        float s = 0.f;
#pragma unroll
        for (int i = 0; i < 4; ++i) s += v[i][0] + v[i][1] + v[i][2] + v[i][3];
        float mu = wave_sum(s) * (1.f / 1024.f); float q = 0.f;
#pragma unroll
        for (int i = 0; i < 4; ++i) { v[i] = v[i] - mu; q += v[i][0] * v[i][0] + v[i][1] * v[i][1] + v[i][2] * v[i][2] + v[i][3] * v[i][3]; }
        float rstd = rsqrtf(wave_sum(q) * (1.f / 1024.f) + 1e-5f);
        s = 0.f;
#pragma unroll
        for (int i = 0; i < 4; ++i) { v[i] = v[i] * rstd * g1[i] + b1[i]; s += v[i][0] + v[i][1] + v[i][2] + v[i][3];
            f16x4 hx; hx[0] = (_Float16)v[i][0]; hx[1] = (_Float16)v[i][1]; hx[2] = (_Float16)v[i][2]; hx[3] = (_Float16)v[i][3];
            __builtin_nontemporal_store(hx, (f16x4*)(X1H + ro + i * 256 + lane * 4)); }
        mu = wave_sum(s) * (1.f / 1024.f); q = 0.f;
#pragma unroll
        for (int i = 0; i < 4; ++i) { v[i] = v[i] - mu; q += v[i][0] * v[i][0] + v[i][1] * v[i][1] + v[i][2] * v[i][2] + v[i][3] * v[i][3]; }
        rstd = rsqrtf(wave_sum(q) * (1.f / 1024.f) + 1e-5f);
#pragma unroll
        for (int i = 0; i < 4; ++i) { const f32x4 hv = v[i] * rstd * sc2[i] + sh2[i]; u32x2 o; o[0] = cvt_pk(hv[0], hv[1]); o[1] = cvt_pk(hv[2], hv[3]);
            *(u32x2*)(H2 + ro + i * 256 + lane * 4) = o; }
    }
}
__device__ void phase_ln_out(const Params& p) {
    const int tid = tid_opaque(), w = blockIdx.x, lane = tid & 63, wid = tid >> 6, b = w >> 6;
    const float* modf = (const float*)(p.ws + OFF_MODF) + b * 6144;
    const _Float16* X1H = (const _Float16*)(p.ws + OFF_X1); const bf16_t* ACC2 = (const bf16_t*)(p.ws + OFF_H2);
    f32x4 g2[4], b2[4], gt2[4];
#pragma unroll
    for (int i = 0; i < 4; ++i) { const int c0 = i * 256 + lane * 4; g2[i] = *(const f32x4*)(p.ln2g + c0); b2[i] = *(const f32x4*)(p.ln2b + c0); gt2[i] = *(const f32x4*)(modf + 5 * 1024 + c0); }
    const size_t r0 = (size_t)(w * 128 + wid * 16) * DM;
    f16x4 nx[4][4]; u32x2 nb[4][4];
#pragma unroll
    for (int pr = 0; pr < 3; ++pr)
#pragma unroll
        for (int i = 0; i < 4; ++i) { nx[pr][i] = __builtin_nontemporal_load((const f16x4*)(X1H + r0 + pr * DM + i * 256 + lane * 4)); nb[pr][i] = __builtin_nontemporal_load((const u32x2*)(ACC2 + r0 + pr * DM + i * 256 + lane * 4)); }
#pragma unroll
    for (int rr = 0; rr < 16; ++rr) { const size_t ro = r0 + (size_t)rr * DM; f32x4 v[4];
        if (rr + 3 < 16) {
#pragma unroll
            for (int i = 0; i < 4; ++i) { nx[(rr + 3) & 3][i] = __builtin_nontemporal_load((const f16x4*)(X1H + ro + 3 * DM + i * 256 + lane * 4)); nb[(rr + 3) & 3][i] = __builtin_nontemporal_load((const u32x2*)(ACC2 + ro + 3 * DM + i * 256 + lane * 4)); } }
#pragma unroll
        for (int i = 0; i < 4; ++i) { const f16x4 hx = nx[rr & 3][i]; const f32x4 x1 = {(float)hx[0], (float)hx[1], (float)hx[2], (float)hx[3]}; v[i] = x1 * ALPHA + gt2[i] * bf4_to_f32(nb[rr & 3][i]); }
        float s = 0.f;
#pragma unroll
        for (int i = 0; i < 4; ++i) s += v[i][0] + v[i][1] + v[i][2] + v[i][3];
        const float mu = wave_sum(s) * (1.f / 1024.f); float q = 0.f;
#pragma unroll
        for (int i = 0; i < 4; ++i) { v[i] = v[i] - mu; q += v[i][0] * v[i][0] + v[i][1] * v[i][1] + v[i][2] * v[i][2] + v[i][3] * v[i][3]; }
        const float rstd = rsqrtf(wave_sum(q) * (1.f / 1024.f) + 1e-5f);
#pragma unroll
        for (int i = 0; i < 4; ++i) __builtin_nontemporal_store(v[i] * rstd * g2[i] + b2[i], (f32x4*)(p.out + ro + i * 256 + lane * 4));
    }
}

__device__ __forceinline__ u32x2 lds_tr_read0(unsigned addr) { u32x2 r; asm volatile("ds_read_b64_tr_b16 %0, %1\n\ts_waitcnt lgkmcnt(0)" : "=&v"(r) : "v"(addr) : "memory"); return r; }
__device__ __forceinline__ void lds_tr_read4(unsigned a0, unsigned a1, unsigned a2, unsigned a3, u32x2& r0, u32x2& r1, u32x2& r2, u32x2& r3) {
    asm volatile("ds_read_b64_tr_b16 %0, %4\n\tds_read_b64_tr_b16 %1, %5\n\tds_read_b64_tr_b16 %2, %6\n\tds_read_b64_tr_b16 %3, %7\n\ts_waitcnt lgkmcnt(0)"
                 : "=&v"(r0), "=&v"(r1), "=&v"(r2), "=&v"(r3) : "v"(a0), "v"(a1), "v"(a2), "v"(a3) : "memory"); }
template <int OFF> __device__ __forceinline__ u32x2 lds_tr_read(unsigned addr) { u32x2 r; asm volatile("ds_read_b64_tr_b16 %0, %1 offset:%2\n\ts_waitcnt lgkmcnt(0)" : "=&v"(r) : "v"(addr), "i"(OFF) : "memory"); return r; }
__device__ __forceinline__ void tr_frags4(unsigned base, unsigned rs, bf16x8 (&fr)[4]) {
    u32x2 r0, r1, r2, r3; u32x4 t;
    lds_tr_read4(base, base + 4 * rs, base + 16 * rs, base + 20 * rs, r0, r1, r2, r3);
    t[0] = r0[0]; t[1] = r0[1]; t[2] = r1[0]; t[3] = r1[1]; fr[0] = __builtin_bit_cast(bf16x8, t); t[0] = r2[0]; t[1] = r2[1]; t[2] = r3[0]; t[3] = r3[1]; fr[1] = __builtin_bit_cast(bf16x8, t);
    lds_tr_read4(base + 32 * rs, base + 36 * rs, base + 48 * rs, base + 52 * rs, r0, r1, r2, r3);
    t[0] = r0[0]; t[1] = r0[1]; t[2] = r1[0]; t[3] = r1[1]; fr[2] = __builtin_bit_cast(bf16x8, t); t[0] = r2[0]; t[1] = r2[1]; t[2] = r3[0]; t[3] = r3[1]; fr[3] = __builtin_bit_cast(bf16x8, t);
}
__device__ __forceinline__ void swa_unit(const Params& p, int unit, LAS unsigned char* lds, const bool inplace_ok) {
    const int kvh = unit & 1, n = (unit >> 1) & 63, b = unit >> 7;
    LAS bf16_t* Ks = (LAS bf16_t*)lds;
    LAS unsigned char* Vs = (LAS unsigned char*)(Ks + 256 * 72);
    bf16_t* proj = (bf16_t*)(p.ws + OFF_PROJ); const float* rope = (const float*)(p.ws + OFF_ROPE);
    const int tid = tid_opaque(), lane = tid & 63, wid = tid >> 6, h = lane >> 5, l31 = lane & 31;
    const int tband0 = b * SEQ + (n - 1) * 128;
    __syncthreads();
#pragma unroll
    for (int i = 0; i < 4; ++i) { const int pidx = tid + 512 * i, key = pidx >> 3, c8 = pidx & 7; const bool valid = (n > 0) || (key >= 128);
        u32x4 o = {0u, 0u, 0u, 0u};
        if (valid) { const int tok = tband0 + key; const bf16_t* src = proj + (size_t)tok * NPJ + C_KB + kvh * 64;
            if (c8 >= 2) o = *(const u32x4*)(src + c8 * 8);
            else { const bf16x8 lo = *(const bf16x8*)(src), hi = *(const bf16x8*)(src + 8); const float* cs = rope + (size_t)tok * 16; float r[8];
#pragma unroll
                for (int e = 0; e < 8; ++e) { const float t1 = bf2f((bf16_t)lo[e]), t2 = bf2f((bf16_t)hi[e]), cc = cs[e], ss = cs[8 + e]; r[e] = (c8 == 0) ? (t1 * cc - t2 * ss) : (t2 * cc + t1 * ss); }
                o[0] = cvt_pk(r[0], r[1]); o[1] = cvt_pk(r[2], r[3]); o[2] = cvt_pk(r[4], r[5]); o[3] = cvt_pk(r[6], r[7]); } }
        *(LAS u32x4*)(Ks + key * 72 + c8 * 8) = o; }
#pragma unroll
    for (int i = 0; i < 4; ++i) { const int pidx = tid + 512 * i, key = pidx >> 3, c8 = pidx & 7; const bool valid = (n > 0) || (key >= 128);
        bf16x8 v = {0, 0, 0, 0, 0, 0, 0, 0};
        if (valid) v = *(const bf16x8*)(proj + (size_t)(tband0 + key) * NPJ + C_VB + kvh * 64 + c8 * 8);
        *(LAS bf16x8*)(Vs + key * 192 + c8 * 16) = v; }
    __syncthreads();
    const int hq = kvh * 8 + wid; const float sink2 = p.sinks[hq] * LOG2E;
    bf16x8 qraw[5]; f32x4 csr[4];
#define SWA_QLOAD(qtn) do { const int tqn = b * SEQ + n * 128 + 32 * (qtn) + l31; const bf16_t* qr = proj + (size_t)tqn * NPJ + C_QB + hq * 64; \
        qraw[0] = *(const bf16x8*)(qr); qraw[1] = *(const bf16x8*)(qr + 8); _Pragma("unroll") for (int s = 1; s < 4; ++s) qraw[1 + s] = *(const bf16x8*)(qr + 16 * s + 8 * h); \
        _Pragma("unroll") for (int j = 0; j < 4; ++j) csr[j] = *(const f32x4*)(rope + (size_t)tqn * 16 + 4 * j); } while (0)
    SWA_QLOAD(0);
    for (int qt = 0; qt < 4; ++qt) {
        const int tq = b * SEQ + n * 128 + 32 * qt + l31; bf16_t* qrow = proj + (size_t)tq * NPJ + C_QB + hq * 64;
        bf16x8 qf[4];
#pragma unroll
        for (int s = 1; s < 4; ++s) qf[s] = qraw[1 + s];
        { const bf16x8 lo = qraw[0], hi = qraw[1]; float r[8];
#pragma unroll
            for (int e = 0; e < 8; ++e) { const float t1 = bf2f((bf16_t)lo[e]), t2 = bf2f((bf16_t)hi[e]), cc = csr[e >> 2][e & 3], ss = csr[2 + (e >> 2)][e & 3]; r[e] = (h == 0) ? (t1 * cc - t2 * ss) : (t2 * cc + t1 * ss); }
            u32x4 o; o[0] = cvt_pk(r[0], r[1]); o[1] = cvt_pk(r[2], r[3]); o[2] = cvt_pk(r[4], r[5]); o[3] = cvt_pk(r[6], r[7]); qf[0] = __builtin_bit_cast(bf16x8, o); }
        if (qt < 3) SWA_QLOAD(qt + 1);
        f32x16 st[5];
        bf16x8 kfr[2][4];
#pragma unroll
        for (int s = 0; s < 4; ++s) kfr[0][s] = *(const LAS bf16x8*)(Ks + (32 * qt + l31) * 72 + 16 * s + 8 * h);
#pragma unroll
        for (int dk = 0; dk < 5; ++dk) { f32x16 a = {0.f, 0.f, 0.f, 0.f, 0.f, 0.f, 0.f, 0.f, 0.f, 0.f, 0.f, 0.f, 0.f, 0.f, 0.f, 0.f};
            if (dk < 4) {
#pragma unroll
                for (int s = 0; s < 4; ++s) kfr[(dk + 1) & 1][s] = *(const LAS bf16x8*)(Ks + (32 * (qt + dk + 1) + l31) * 72 + 16 * s + 8 * h); }
#pragma unroll
            for (int s = 0; s < 4; ++s) a = __builtin_amdgcn_mfma_f32_32x32x16_bf16(kfr[dk & 1][s], qf[s], a, 0, 0, 0);
            st[dk] = a; }
        float mx = -INFINITY;
#pragma unroll
        for (int dk = 0; dk < 5; ++dk) { const bool dead = (n == 0) && (qt + dk < 4);
#pragma unroll
            for (int r = 0; r < 16; ++r) { const int cidx = (r & 3) + 8 * (r >> 2) + 4 * h; bool ok = !dead; if (dk == 0) ok = ok && (cidx > l31); if (dk == 4) ok = ok && (cidx <= l31);
                const float v = ok ? st[dk][r] * (0.125f * LOG2E) : -INFINITY; st[dk][r] = v; mx = fmaxf(mx, v); } }
        { const auto pr = __builtin_amdgcn_permlane32_swap(__float_as_uint(mx), __float_as_uint(mx), false, false);
            mx = fmaxf(__uint_as_float(pr[0]), __uint_as_float(pr[1])); }
        mx = fmaxf(mx, sink2);
        float sum = 0.f;
#pragma unroll
        for (int dk = 0; dk < 5; ++dk)
#pragma unroll
            for (int r = 0; r < 16; ++r) { const float pv = __builtin_amdgcn_exp2f(st[dk][r] - mx); st[dk][r] = pv; sum += pv; }
        { const auto pr = __builtin_amdgcn_permlane32_swap(__float_as_uint(sum), __float_as_uint(sum), false, false); sum = __uint_as_float(pr[0]) + __uint_as_float(pr[1]); }
        sum += __builtin_amdgcn_exp2f(sink2 - mx);
        const unsigned va = (unsigned)(size_t)Vs + (unsigned)((32 * qt + 4 * h + ((lane & 15) >> 2)) * 192 + (16 * ((lane >> 4) & 1) + 4 * (lane & 3)) * 2);
        f32x16 oacc[2];
#pragma unroll
        for (int dt = 0; dt < 2; ++dt) oacc[dt] = (f32x16){0.f, 0.f, 0.f, 0.f, 0.f, 0.f, 0.f, 0.f, 0.f, 0.f, 0.f, 0.f, 0.f, 0.f, 0.f, 0.f};
#pragma unroll
        for (int dk = 0; dk < 5; ++dk)
#pragma unroll
            for (int s2 = 0; s2 < 2; ++s2) { u32x4 pp;
#pragma unroll
                for (int j = 0; j < 4; ++j) pp[j] = cvt_pk(st[dk][8 * s2 + 2 * j], st[dk][8 * s2 + 2 * j + 1]);
                const bf16x8 pf = __builtin_bit_cast(bf16x8, pp);
                u32x2 vlo[2], vhi[2];
                { const unsigned ab = va + (unsigned)((32 * dk + 16 * s2) * 192); lds_tr_read4(ab, ab + 8 * 192, ab + 64, ab + 8 * 192 + 64, vlo[0], vhi[0], vlo[1], vhi[1]); }
#pragma unroll
                for (int dt = 0; dt < 2; ++dt) { const u32x2 lo = vlo[dt], hi = vhi[dt];
                    u32x4 vv; vv[0] = lo[0]; vv[1] = lo[1]; vv[2] = hi[0]; vv[3] = hi[1];
                    oacc[dt] = __builtin_amdgcn_mfma_f32_32x32x16_bf16(__builtin_bit_cast(bf16x8, vv), pf, oacc[dt], 0, 0, 0); } }
        const float inv = 1.f / sum;
#pragma unroll
        for (int dt = 0; dt < 2; ++dt)
#pragma unroll
            for (int g = 0; g < 4; ++g) { u32x2 o; o[0] = cvt_pk(oacc[dt][4 * g] * inv, oacc[dt][4 * g + 1] * inv); o[1] = cvt_pk(oacc[dt][4 * g + 2] * inv, oacc[dt][4 * g + 3] * inv);
                if (inplace_ok) *(u32x2*)(qrow + 32 * dt + 8 * g + 4 * h) = o; }
    }
}

#undef SWA_QLOAD
__device__ __forceinline__ void gla_a_unit(const Params& p, int unit, LAS unsigned char* lds, const bool inplace_ok) {
    const int sc = unit & 15, hh = (unit >> 4) & 3, b = unit >> 6;
    LAS float* s_w = (LAS float*)lds; LAS float* s_wt = s_w + 2048; LAS float* s_dec = s_wt + 1024; LAS float* s_bl = s_dec + 128; LAS float* s_gs = s_bl + 128;
    LAS bf16_t* Qm = (LAS bf16_t*)(lds + 16384); LAS bf16_t* Km = Qm + 64 * 136; LAS unsigned char* Ko = lds + 51200; LAS unsigned char* Vs = lds + 71680;
    bf16_t* proj = (bf16_t*)(p.ws + OFF_PROJ); float* DEC = (float*)(p.ws + OFF_DEC); float* DSUP = (float*)(p.ws + OFF_DSUP);
    bf16_t* KOT = (bf16_t*)((unsigned char*)p.out + OO_KOT); bf16_t* ABUF = (bf16_t*)((unsigned char*)p.out + OO_ABUF); _Float16* USUP = (_Float16*)((unsigned char*)p.out + OO_USUP);
    const int tid0 = threadIdx.x; int tid = tid0, lane = tid & 63, wid = tid >> 6, h = lane >> 5, l31 = lane & 31, kg = tid & 15, pp = tid >> 4;
    float wtmp[4], btmp = 0.f;
#pragma unroll
    for (int i = 0; i < 4; ++i) { const int idx = tid + 512 * i; wtmp[i] = p.w_lr[(idx >> 7) * 512 + hh * 128 + (idx & 127)]; }
    if (tid < 128) btmp = p.b_lr[hh * 128 + tid];
    f32x16 S[4];
#pragma unroll
    for (int mt = 0; mt < 4; ++mt) S[mt] = (f32x16){0.f, 0.f, 0.f, 0.f, 0.f, 0.f, 0.f, 0.f, 0.f, 0.f, 0.f, 0.f, 0.f, 0.f, 0.f, 0.f};
    const int tbase = b * SEQ + sc * 512, ubase = (b * 4 + hh) * 128 + sc * 8;
    bf16x8 sq[2], sk[2], sl[2][2], sv[4];
#define GLA_ISSUE(c8n) do { const int t0n = tbase + (c8n) * 64; \
        _Pragma("unroll") for (int j = 0; j < 2; ++j) { const bf16_t* row = proj + (size_t)(t0n + 2 * pp + j) * NPJ; \
            sq[j] = __builtin_nontemporal_load((const bf16x8*)(row + hh * HB + H_Q + 8 * kg)); sk[j] = __builtin_nontemporal_load((const bf16x8*)(row + hh * HB + H_K + 8 * kg)); sl[j][0] = __builtin_nontemporal_load((const bf16x8*)(row + C_LR)); sl[j][1] = __builtin_nontemporal_load((const bf16x8*)(row + C_LR + 8)); } \
        } while (0)
#define GLA_ISSUE_V(c8n) do { const int t0n = tbase + (c8n) * 64; \
        _Pragma("unroll") for (int i = 0; i < 4; ++i) { const int pidx = tid + 512 * i; sv[i] = __builtin_nontemporal_load((const bf16x8*)(proj + (size_t)(t0n + (pidx >> 5)) * NPJ + hh * HB + H_V + (pidx & 31) * 8)); } } while (0)
    GLA_ISSUE(0); GLA_ISSUE_V(0);
    __syncthreads();
#pragma unroll
    for (int i = 0; i < 4; ++i) s_w[tid + 512 * i] = wtmp[i];
    if (tid < 128) { s_bl[tid] = btmp; s_gs[tid] = 0.f; }
    __syncthreads();
    for (int c8 = 0; c8 < 8; ++c8) {
        const int t0 = tbase + c8 * 64, u = ubase + c8;
        tid = tid0; asm volatile("" : "+v"(tid));
        lane = tid & 63; wid = __builtin_amdgcn_readfirstlane(tid >> 6); h = lane >> 5; l31 = lane & 31; kg = tid & 15; pp = tid >> 4;
        const int grp = lane >> 4;
        lds_barrier();
#pragma unroll
        for (int i = 0; i < 4; ++i) { const int pidx = tid + 512 * i; *(LAS bf16x8*)(Vs + (pidx >> 5) * 576 + (pidx & 31) * 16) = sv[i]; }
        if (c8 < 7) GLA_ISSUE_V(c8 + 1);
        float z[2][8];
        { const f32x4 b0 = *(const LAS f32x4*)(s_bl + 8 * kg), b1 = *(const LAS f32x4*)(s_bl + 8 * kg + 4);
#pragma unroll
            for (int j = 0; j < 2; ++j)
#pragma unroll
                for (int e = 0; e < 4; ++e) { z[j][e] = b0[e]; z[j][4 + e] = b1[e]; } }
#pragma unroll
        for (int r = 0; r < 16; ++r) { const f32x4 w0 = *(const LAS f32x4*)(s_w + r * 128 + 8 * kg), w1 = *(const LAS f32x4*)(s_w + r * 128 + 8 * kg + 4);
#pragma unroll
            for (int j = 0; j < 2; ++j) { const float f = bf2f((bf16_t)sl[j][r >> 3][r & 7]);
#pragma unroll
                for (int e = 0; e < 4; ++e) { z[j][e] += f * w0[e]; z[j][4 + e] += f * w1[e]; } } }
        float c0[8], tot[8], sN[8];
#pragma unroll
        for (int e = 0; e < 8; ++e) {
            const float la0 = -(fmaxf(-z[0][e], 0.f) * (0.0625f * LOG2E) + __builtin_amdgcn_logf(1.f + __builtin_amdgcn_exp2f(-fabsf(z[0][e]) * LOG2E)) * 0.0625f),
                        la1 = -(fmaxf(-z[1][e], 0.f) * (0.0625f * LOG2E) + __builtin_amdgcn_logf(1.f + __builtin_amdgcn_exp2f(-fabsf(z[1][e]) * LOG2E)) * 0.0625f);
            c0[e] = la0; tot[e] = la0 + la1; float sv_ = tot[e];
            float t = __shfl_up(sv_, 16); if (grp >= 1) sv_ += t;
            t = __shfl_up(sv_, 32); if (grp >= 2) sv_ += t;
            sN[e] = sv_; }
        if (grp == 3) { f32x4 a0, a1;
#pragma unroll
            for (int e = 0; e < 4; ++e) { a0[e] = sN[e]; a1[e] = sN[4 + e]; }
            *(LAS f32x4*)(s_wt + wid * 128 + 8 * kg) = a0; *(LAS f32x4*)(s_wt + wid * 128 + 8 * kg + 4) = a1; }
        lds_barrier();
        float g0[8], gmid[8], glast[8];
#pragma unroll
        for (int e = 0; e < 8; ++e) { g0[e] = sN[e] - tot[e] + c0[e]; glast[e] = 0.f; gmid[e] = 0.f; }
#pragma unroll
        for (int w2 = 0; w2 < 8; ++w2) { const f32x4 a0 = *(const LAS f32x4*)(s_wt + w2 * 128 + 8 * kg), a1 = *(const LAS f32x4*)(s_wt + w2 * 128 + 8 * kg + 4);
            if (w2 == wid) {
#pragma unroll
                for (int e = 0; e < 8; ++e) g0[e] += glast[e]; }
#pragma unroll
            for (int e = 0; e < 8; ++e) glast[e] += (e < 4) ? a0[e & 3] : a1[e & 3];
            if (w2 == 3) {
#pragma unroll
                for (int e = 0; e < 8; ++e) gmid[e] = glast[e]; } }
#pragma unroll
        for (int j = 0; j < 2; ++j) { const int tok = 2 * pp + j; u32x4 o4; float gg[8];
#pragma unroll
            for (int e = 0; e < 8; ++e) gg[e] = g0[e] + ((j == 0) ? 0.f : (tot[e] - c0[e]));
#pragma unroll
            for (int e = 0; e < 4; ++e) o4[e] = cvt_pk(bf2f((bf16_t)sq[j][2 * e]) * __builtin_amdgcn_exp2f(gg[2 * e]), bf2f((bf16_t)sq[j][2 * e + 1]) * __builtin_amdgcn_exp2f(gg[2 * e + 1]));
            if (inplace_ok) *(u32x4*)(proj + (size_t)(t0 + tok) * NPJ + hh * HB + H_Q + 8 * kg) = o4;
#pragma unroll
            for (int e = 0; e < 4; ++e) o4[e] = cvt_pk(bf2f((bf16_t)sq[j][2 * e]) * __builtin_amdgcn_exp2f(gg[2 * e] - gmid[2 * e]), bf2f((bf16_t)sq[j][2 * e + 1]) * __builtin_amdgcn_exp2f(gg[2 * e + 1] - gmid[2 * e + 1]));
            *(LAS u32x4*)(Qm + tok * 136 + 8 * kg) = o4;
#pragma unroll
            for (int e = 0; e < 4; ++e) o4[e] = cvt_pk(bf2f((bf16_t)sk[j][2 * e]) * __builtin_amdgcn_exp2f(gmid[2 * e] - gg[2 * e]), bf2f((bf16_t)sk[j][2 * e + 1]) * __builtin_amdgcn_exp2f(gmid[2 * e + 1] - gg[2 * e + 1]));
            *(LAS u32x4*)(Km + tok * 136 + 8 * kg) = o4;
#pragma unroll
            for (int e = 0; e < 4; ++e) o4[e] = cvt_pk(bf2f((bf16_t)sk[j][2 * e]) * __builtin_amdgcn_exp2f(glast[2 * e] - gg[2 * e]), bf2f((bf16_t)sk[j][2 * e + 1]) * __builtin_amdgcn_exp2f(glast[2 * e + 1] - gg[2 * e + 1]));
            *(LAS u32x4*)(Ko + tok * 320 + kg * 16) = o4; *(u32x4*)(KOT + ((size_t)u * 64 + tok) * 128 + 8 * kg) = o4; }
        if (pp == 0) { f32x4 d0, d1;
#pragma unroll
            for (int e = 0; e < 4; ++e) { d0[e] = __builtin_amdgcn_exp2f(glast[e]); d1[e] = __builtin_amdgcn_exp2f(glast[4 + e]); }
            { f32x4 s0 = *(const LAS f32x4*)(s_gs + 8 * kg), s1 = *(const LAS f32x4*)(s_gs + 8 * kg + 4);
#pragma unroll
                for (int e = 0; e < 4; ++e) { s0[e] += glast[e]; s1[e] += glast[4 + e]; }
                *(LAS f32x4*)(s_gs + 8 * kg) = s0; *(LAS f32x4*)(s_gs + 8 * kg + 4) = s1; }
            *(LAS f32x4*)(s_dec + 8 * kg) = d0; *(LAS f32x4*)(s_dec + 8 * kg + 4) = d1; *(f32x4*)(DEC + u * 128 + 8 * kg) = d0; *(f32x4*)(DEC + u * 128 + 8 * kg + 4) = d1; }
        if (c8 < 7) GLA_ISSUE(c8 + 1);
        lds_barrier();
        { const int mi = wid >> 1, fr = lane & 15, fq = lane >> 4;
#pragma unroll
            for (int nn = 0; nn < 2; ++nn) { const int nj = 2 * (wid & 1) + nn; f32x4 a = {0.f, 0.f, 0.f, 0.f};
                if (nj <= mi) {
#pragma unroll
                    for (int s = 0; s < 4; ++s) { const bf16x8 qa = *(const LAS bf16x8*)(Qm + (16 * mi + fr) * 136 + 32 * s + 8 * fq), ka = *(const LAS bf16x8*)(Km + (16 * nj + fr) * 136 + 32 * s + 8 * fq);
                        a = __builtin_amdgcn_mfma_f32_16x16x32_bf16(ka, qa, a, 0, 0, 0); } }
                const int ii = 16 * mi + fr, j0 = 16 * nj + 4 * fq; u32x2 o;
                o[0] = cvt_pk((j0 + 0 <= ii) ? a[0] : 0.f, (j0 + 1 <= ii) ? a[1] : 0.f); o[1] = cvt_pk((j0 + 2 <= ii) ? a[2] : 0.f, (j0 + 3 <= ii) ? a[3] : 0.f);
                *(u32x2*)(ABUF + (size_t)u * 4096 + ii * 64 + j0) = o; } }
#pragma unroll
        for (int mt = 0; mt < 4; ++mt)
#pragma unroll
            for (int g = 0; g < 4; ++g) { const f32x4 d4 = *(const LAS f32x4*)(s_dec + 32 * mt + 8 * g + 4 * h);
#pragma unroll
                for (int e = 0; e < 4; ++e) S[mt][4 * g + e] *= d4[e]; }
        const unsigned trb = (unsigned)((8 * h + ((lane & 15) >> 2)));
        const unsigned trc = (unsigned)((16 * ((lane >> 4) & 1) + 4 * (lane & 3)) * 2);
        bf16x8 vb[4]; tr_frags4((unsigned)(size_t)Vs + trb * 576u + (unsigned)(32 * wid * 2) + trc, 576u, vb);
#pragma unroll
        for (int mt = 0; mt < 4; ++mt) { bf16x8 ka[4]; tr_frags4((unsigned)(size_t)Ko + trb * 320u + (unsigned)(32 * mt * 2) + trc, 320u, ka);
#pragma unroll
            for (int s = 0; s < 4; ++s) S[mt] = __builtin_amdgcn_mfma_f32_32x32x16_bf16(ka[s], vb[s], S[mt], 0, 0, 0); }
    }
#undef GLA_ISSUE
#undef GLA_ISSUE_V
#pragma unroll
    for (int mt = 0; mt < 4; ++mt)
#pragma unroll
        for (int r = 0; r < 16; ++r) USUP[((size_t)unit * 128 + 32 * mt + (r & 3) + 8 * (r >> 2) + 4 * h) * 256 + 32 * wid + l31] = (_Float16)S[mt][r];
    if (pp == 0) {
#pragma unroll
        for (int e = 0; e < 8; ++e) DSUP[unit * 128 + 8 * kg + e] = __builtin_amdgcn_exp2f(s_gs[8 * kg + e]); }
}
__device__ void gla_scan(const Params& p) {
    _Float16* USUP = (_Float16*)((unsigned char*)p.out + OO_USUP); const float* DSUP = (const float*)(p.ws + OFF_DSUP);
    const int e = blockIdx.x * 512 + tid_opaque(), bh = e >> 13, w = e & 8191, kd = w >> 6, v4 = w & 63;
    f16x4 uh[16]; float dd[16];
#pragma unroll
    for (int sc = 0; sc < 16; ++sc) { uh[sc] = __builtin_nontemporal_load((const f16x4*)(USUP + ((size_t)(bh * 16 + sc) * 128 + kd) * 256 + v4 * 4)); dd[sc] = DSUP[(bh * 16 + sc) * 128 + kd]; }
    f32x4 S = {0.f, 0.f, 0.f, 0.f};
#pragma unroll
    for (int sc = 0; sc < 16; ++sc) { f16x4 sh; sh[0] = (_Float16)S[0]; sh[1] = (_Float16)S[1]; sh[2] = (_Float16)S[2]; sh[3] = (_Float16)S[3];
        *(f16x4*)(USUP + ((size_t)(bh * 16 + sc) * 128 + kd) * 256 + v4 * 4) = sh;
        const f32x4 uu = {(float)uh[sc][0], (float)uh[sc][1], (float)uh[sc][2], (float)uh[sc][3]}; S = S * dd[sc] + uu; }
}
__device__ __forceinline__ void gla_b_unit(const Params& p, int unit, LAS unsigned char* lds, const bool inplace_ok) {
    const int sc = unit & 15, hh = (unit >> 4) & 3, b = unit >> 6;
    LAS unsigned char* Ko = lds + 36864; LAS bf16_t* Qi = (LAS bf16_t*)(lds + 57344); LAS bf16_t* As = Qi + 64 * 136; LAS float* s_dec = (LAS float*)(lds + 83968);
    LAS float* Os = (LAS float*)(lds + 84992);
    bf16_t* proj = (bf16_t*)(p.ws + OFF_PROJ); const float* DEC = (const float*)(p.ws + OFF_DEC);
    const bf16_t* KOT = (const bf16_t*)((unsigned char*)p.out + OO_KOT); const bf16_t* ABUF = (const bf16_t*)((unsigned char*)p.out + OO_ABUF); const _Float16* USUP = (const _Float16*)((unsigned char*)p.out + OO_USUP);
    const int tid0 = threadIdx.x; int tid = tid0, lane = tid & 63, wid = tid >> 6, h = lane >> 5, l31 = lane & 31;
    int tokl = tid >> 5, c8i = tid & 31;
    const f32x4 gn0 = *(const f32x4*)(p.gnorm + 8 * c8i), gn1 = *(const f32x4*)(p.gnorm + 8 * c8i + 4);
    bf16x8 sv[4]; u32x4 sk[2], sq[2], sa; float sd = 0.f;
    const int tbase = b * SEQ + sc * 512, ubase = (b * 4 + hh) * 128 + sc * 8;
#define GLB_ISSUE(c8n) do { const int t0n = tbase + (c8n) * 64, un = ubase + (c8n); \
        _Pragma("unroll") for (int i = 0; i < 4; ++i) { const int pidx = tid + 512 * i, tok = pidx >> 5, cc = pidx & 31; sv[i] = __builtin_nontemporal_load((const bf16x8*)(proj + (size_t)(t0n + tok) * NPJ + hh * HB + H_V + cc * 8)); } \
        _Pragma("unroll") for (int i = 0; i < 2; ++i) { const int pidx = tid + 512 * i; sk[i] = __builtin_nontemporal_load((const u32x4*)(KOT + (size_t)un * 8192 + (size_t)pidx * 8)); \
            sq[i] = __builtin_nontemporal_load((const u32x4*)(proj + (size_t)(t0n + (pidx >> 4)) * NPJ + hh * HB + H_Q + (pidx & 15) * 8)); } \
        sa = __builtin_nontemporal_load((const u32x4*)(ABUF + (size_t)un * 4096 + (tid >> 3) * 64 + (tid & 7) * 8)); if (tid < 128) sd = DEC[un * 128 + tid]; } while (0)
    __syncthreads();
    GLB_ISSUE(0);
    f32x16 S[4];
#pragma unroll
    for (int mt = 0; mt < 4; ++mt)
#pragma unroll
        for (int r = 0; r < 16; ++r) S[mt][r] = (float)USUP[((size_t)unit * 128 + 32 * mt + (r & 3) + 8 * (r >> 2) + 4 * h) * 256 + 32 * wid + l31];
    for (int c8 = 0; c8 < 8; ++c8) {
        const int t0 = tbase + c8 * 64;
        tid = tid0; asm volatile("" : "+v"(tid));
        lane = tid & 63; wid = __builtin_amdgcn_readfirstlane(tid >> 6); h = lane >> 5; l31 = lane & 31; tokl = tid >> 5; c8i = tid & 31;
        lds_barrier();
#pragma unroll
        for (int i = 0; i < 4; ++i) { const int pidx = tid + 512 * i, tok = pidx >> 5, cc = pidx & 31; *(LAS bf16x8*)(lds + tok * 576 + cc * 16) = sv[i]; }
#pragma unroll
        for (int i = 0; i < 2; ++i) { const int pidx = tid + 512 * i; *(LAS u32x4*)(Ko + (pidx >> 4) * 320 + (pidx & 15) * 16) = sk[i]; *(LAS u32x4*)(Qi + (pidx >> 4) * 136 + (pidx & 15) * 8) = sq[i]; }
        *(LAS u32x4*)(As + (tid >> 3) * 72 + (tid & 7) * 8) = sa;
        if (tid < 128) s_dec[tid] = sd;
        lds_barrier();
        bf16x8 wa[4], gb[4], yb[4];
#pragma unroll
        for (int ps = 0; ps < 2; ++ps) { const bf16_t* base = proj + (size_t)(t0 + ps * 16 + tokl) * NPJ + 8 * c8i;
            wa[ps] = __builtin_nontemporal_load((const bf16x8*)(base + hh * HB + H_WA)); gb[ps] = __builtin_nontemporal_load((const bf16x8*)(base + hh * HB + H_GB)); yb[ps] = __builtin_nontemporal_load((const bf16x8*)(base + C_QB + hh * 256)); }
        f32x16 o[2];
#pragma unroll
        for (int it = 0; it < 2; ++it) o[it] = (f32x16){0.f, 0.f, 0.f, 0.f, 0.f, 0.f, 0.f, 0.f, 0.f, 0.f, 0.f, 0.f, 0.f, 0.f, 0.f, 0.f};
        const unsigned trb = (unsigned)((8 * h + ((lane & 15) >> 2))), trc = (unsigned)((16 * ((lane >> 4) & 1) + 4 * (lane & 3)) * 2);
        bf16x8 vb[4]; tr_frags4((unsigned)(size_t)lds + trb * 576u + (unsigned)(32 * wid * 2) + trc, 576u, vb);
#pragma unroll
        for (int it = 0; it < 2; ++it)
#pragma unroll
            for (int s = 0; s < 4; ++s) { if (it == 0 && s >= 2) continue; const bf16x8 af = *(const LAS bf16x8*)(As + (32 * it + l31) * 72 + 16 * s + 8 * h); o[it] = __builtin_amdgcn_mfma_f32_32x32x16_bf16(af, vb[s], o[it], 0, 0, 0); }
#pragma unroll
        for (int mt = 0; mt < 4; ++mt) { u32x4 qq[2][2], sp[2];
#pragma unroll
            for (int s2 = 0; s2 < 2; ++s2)
#pragma unroll
                for (int it = 0; it < 2; ++it) { const LAS bf16_t* qp = Qi + (32 * it + l31) * 136 + 32 * mt + 16 * s2 + 4 * h;
                    const u32x2 lo = *(const LAS u32x2*)qp, hi = *(const LAS u32x2*)(qp + 8); qq[s2][it][0] = lo[0]; qq[s2][it][1] = lo[1]; qq[s2][it][2] = hi[0]; qq[s2][it][3] = hi[1]; }
#pragma unroll
            for (int s2 = 0; s2 < 2; ++s2)
#pragma unroll
                for (int j = 0; j < 4; ++j) sp[s2][j] = cvt_pk(S[mt][8 * s2 + 2 * j], S[mt][8 * s2 + 2 * j + 1]);
#pragma unroll
            for (int s2 = 0; s2 < 2; ++s2)
#pragma unroll
                for (int it = 0; it < 2; ++it) o[it] = __builtin_amdgcn_mfma_f32_32x32x16_bf16(__builtin_bit_cast(bf16x8, qq[s2][it]), __builtin_bit_cast(bf16x8, sp[s2]), o[it], 0, 0, 0); }
#pragma unroll
        for (int mt = 0; mt < 4; ++mt)
#pragma unroll
            for (int g = 0; g < 4; ++g) { const f32x4 d4 = *(const LAS f32x4*)(s_dec + 32 * mt + 8 * g + 4 * h);
#pragma unroll
                for (int e = 0; e < 4; ++e) S[mt][4 * g + e] *= d4[e]; }
#pragma unroll
        for (int mt = 0; mt < 4; ++mt) { bf16x8 ka[4]; tr_frags4((unsigned)(size_t)Ko + trb * 320u + (unsigned)(32 * mt * 2) + trc, 320u, ka);
#pragma unroll
            for (int s = 0; s < 4; ++s) S[mt] = __builtin_amdgcn_mfma_f32_32x32x16_bf16(ka[s], vb[s], S[mt], 0, 0, 0); }
#pragma unroll
        for (int ps = 2; ps < 4; ++ps) { const bf16_t* base = proj + (size_t)(t0 + ps * 16 + tokl) * NPJ + 8 * c8i;
            wa[ps] = __builtin_nontemporal_load((const bf16x8*)(base + hh * HB + H_WA)); gb[ps] = __builtin_nontemporal_load((const bf16x8*)(base + hh * HB + H_GB)); yb[ps] = __builtin_nontemporal_load((const bf16x8*)(base + C_QB + hh * 256)); }
#pragma unroll
        for (int it = 0; it < 2; ++it)
#pragma unroll
            for (int r = 0; r < 16; ++r) Os[(32 * it + (r & 3) + 8 * (r >> 2) + 4 * h) * 260 + 32 * wid + l31] = o[it][r];
        lds_barrier();
        if (c8 < 7) GLB_ISSUE(c8 + 1);
#pragma unroll
        for (int ps = 0; ps < 4; ++ps) { const int tok = ps * 16 + tokl; const LAS float* orow = Os + tok * 260 + 8 * c8i;
            const f32x4 o0 = *(const LAS f32x4*)orow, o1 = *(const LAS f32x4*)(orow + 4);
            float ss = o0[0] * o0[0] + o0[1] * o0[1] + o0[2] * o0[2] + o0[3] * o0[3] + o1[0] * o1[0] + o1[1] * o1[1] + o1[2] * o1[2] + o1[3] * o1[3];
            ss += __builtin_bit_cast(float, __builtin_amdgcn_update_dpp(0, __builtin_bit_cast(int, ss), 0xB1, 0xF, 0xF, true));
            ss += __builtin_bit_cast(float, __builtin_amdgcn_update_dpp(0, __builtin_bit_cast(int, ss), 0x4E, 0xF, 0xF, true));
            ss += __builtin_bit_cast(float, __builtin_amdgcn_update_dpp(0, __builtin_bit_cast(int, ss), 0x141, 0xF, 0xF, true));
            ss += __builtin_bit_cast(float, __builtin_amdgcn_update_dpp(0, __builtin_bit_cast(int, ss), 0x140, 0xF, 0xF, true));
            ss += __shfl_xor(ss, 16);
            const float rinv = rsqrtf(ss * (1.f / 256.f) + 1e-6f); float y[8];
#pragma unroll
            for (int e = 0; e < 8; ++e) { const float ovv = (e < 4) ? o0[e & 3] : o1[e & 3], gn = (e < 4) ? gn0[e & 3] : gn1[e & 3];
                y[e] = bf2f((bf16_t)wa[ps][e]) * (ovv * rinv * gn) + sigmoidf_(bf2f((bf16_t)gb[ps][e])) * bf2f((bf16_t)yb[ps][e]); }
            u32x4 o4; o4[0] = cvt_pk(y[0], y[1]); o4[1] = cvt_pk(y[2], y[3]); o4[2] = cvt_pk(y[4], y[5]); o4[3] = cvt_pk(y[6], y[7]);
            if (inplace_ok) *(u32x4*)(proj + (size_t)(t0 + tok) * NPJ + C_QB + hh * 256 + 8 * c8i) = o4; }
    }
#undef GLB_ISSUE
}

__device__ __forceinline__ Params load_params() {
#if defined(__HIP_DEVICE_COMPILE__)
    const __attribute__((address_space(4))) Params* kp = (const __attribute__((address_space(4))) Params*)__builtin_amdgcn_kernarg_segment_ptr();
    asm volatile("" : "+s"(kp)); Params q;
    q.x = kp->x; q.c = kp->c; q.pos = kp->pos; q.w_ada = kp->w_ada; q.b_ada = kp->b_ada; q.w_in = kp->w_in; q.w_lr = kp->w_lr; q.b_lr = kp->b_lr; q.gnorm = kp->gnorm; q.sinks = kp->sinks; q.w_o = kp->w_o;
    q.ln1g = kp->ln1g; q.ln1b = kp->ln1b; q.w_up = kp->w_up; q.conv_w = kp->conv_w; q.conv_b = kp->conv_b; q.w_down = kp->w_down; q.ln2g = kp->ln2g; q.ln2b = kp->ln2b; q.out = kp->out; q.ws = kp->ws;
    return q;
#else
    return Params{};
#endif
}
__global__ void __launch_bounds__(NTH, 2) mega(Params p) {
    extern __shared__ __attribute__((aligned(16))) unsigned char shm[];
    LAS unsigned char* lds = (LAS unsigned char*)shm;
    cg::grid_group grid = cg::this_grid();
    const int w = blockIdx.x;
    volatile LAS unsigned* xst = (volatile LAS unsigned*)(lds + LDS_BYTES - 16);
    if (threadIdx.x == 0) { xst[0] = 0u; xst[1] = 0u; }
    __syncthreads();
    const XcdBarrier xb = xcd_barrier_post((unsigned*)(p.ws + OFF_BAR), xst);
    if (p.ws == nullptr) grid.sync();
#ifndef PROBE_DUP
#define PROBE_DUP 0
#endif
#if PROBE_DUP & 1
    { const Params q = load_params(); phase0(q, lds); }
    xcd_barrier(xb);
    { const Params q = load_params(); phase_ln_in(q, lds); weight_tiles(q, lds, 0, 1664); }
    xcd_barrier(xb);
#endif
    { const Params q = load_params(); phase0(q, lds); }
    xcd_barrier(xb);
    { const Params q = load_params(); phase_ln_in(q, lds); weight_tiles(q, lds, 0, 1664); }
    xcd_barrier(xb);
    { const Params q = load_params(); { bf16_t* proj = (bf16_t*)(q.ws + OFF_PROJ); pg8::Gemm g{(const bf16_t*)((unsigned char*)q.out + OO_H), (const bf16_t*)(q.ws + OFF_WIN), 128, 26, 1024, 1024, 64}; pg8::StaticOrder so; so.init(128, 26, NWG, w); EpiProjIn e{proj}; pg8::gemm_phase(lds, g, so, e); } }
    xcd_barrier(xb);
#if PROBE_DUP & 2
    { const Params q = load_params(); const bool ok = (q.ws == nullptr); for (int u = w; u < 512; u += NWG) swa_unit(q, u, lds, ok); }
    xcd_barrier(xb);
#endif
#if PROBE_DUP & 32
    { const Params q = load_params(); const bool ok = (q.ws == nullptr); gla_a_unit(q, w, lds, ok); }
    xcd_barrier(xb);
#endif
    { const Params q = load_params(); for (int u = w; u < 512; u += NWG) swa_unit(q, u, lds, true); gla_a_unit(q, w, lds, true); }
    xcd_barrier(xb);
    { const Params q = load_params(); gla_scan(q); weight_tiles(q, lds, 1664, 4032); }
    xcd_barrier(xb);
#if PROBE_DUP & 4
    { const Params q = load_params(); const bool ok = (q.ws == nullptr); gla_b_unit(q, w, lds, ok); }
    xcd_barrier(xb);
#endif
    { const Params q = load_params(); gla_b_unit(q, w, lds, true); }
    xcd_barrier(xb);
    { const Params q = load_params(); { bf16_t* proj = (bf16_t*)(q.ws + OFF_PROJ); pg8::Gemm g{proj + C_QB, (const bf16_t*)(q.ws + OFF_WO), 128, 4, 1024, NPJ, 64}; pg8::StaticOrder so; so.init(128, 4, NWG, w); EpiProj e{(bf16_t*)(q.ws + OFF_ACC1), 1024}; pg8::gemm_phase(lds, g, so, e); } }
    xcd_barrier(xb);
#if PROBE_DUP & 8
    { const Params q = load_params(); phase_ln_mid(q); }
    xcd_barrier(xb);
#endif
    { const Params q = load_params(); phase_ln_mid(q); }
    xcd_barrier(xb);
    { const Params q = load_params(); { pg8::Gemm g{(const bf16_t*)(q.ws + OFF_H2), (const bf16_t*)(q.ws + OFF_WUP), 128, 22, 1024, 1024, 64}; pg8::StaticOrder so; so.init(128, 22, NWG, w); EpiUp e{(bf16_t*)(q.ws + OFF_F), q.conv_w, q.conv_b, (bf16_t*)(q.ws + OFF_HT)}; pg8::gemm_phase(lds, g, so, e); } }
    xcd_barrier(xb);
    { const Params q = load_params(); conv_seams(q); }
    xcd_barrier(xb);
    { const Params q = load_params(); { pg8::Gemm g{(const bf16_t*)(q.ws + OFF_F), (const bf16_t*)(q.ws + OFF_WDN), 128, 4, DFF, DFF, 64}; pg8::StaticOrder so; so.init(128, 4, NWG, w); EpiProj e{(bf16_t*)(q.ws + OFF_H2), 1024}; pg8::gemm_phase(lds, g, so, e); } }
    xcd_barrier(xb);
#if PROBE_DUP & 16
    { const Params q = load_params(); phase_ln_out(q); }
    xcd_barrier(xb);
#endif
    { const Params q = load_params(); phase_ln_out(q); }
}

extern "C" void kernel_launch(void* const* d_in, const int* in_sizes, int n_in, void* d_out, int out_size, void* d_ws, size_t ws_size, hipStream_t stream) {
    static int ready = 0;
    if (ready == 0) {
        ready = 1;
        if (n_in != 19 || out_size != T_TOK * DM || ws_size < WS_NEED) { fprintf(stderr, "kernel_launch: unexpected shapes (n_in %d out %d ws %zu need %zu)\n", n_in, out_size, ws_size, (size_t)WS_NEED); ready = -1; }
        else if (hipFuncSetAttribute((const void*)mega, hipFuncAttributeMaxDynamicSharedMemorySize, LDS_BYTES) != hipSuccess) { fprintf(stderr, "kernel_launch: hipFuncSetAttribute failed\n"); ready = -1; }
        else { int per_cu = 0; if (hipOccupancyMaxActiveBlocksPerMultiprocessor(&per_cu, (const void*)mega, NTH, LDS_BYTES) != hipSuccess || per_cu < 1) fprintf(stderr, "kernel_launch: occupancy query says %d blocks/CU\n", per_cu); (void)hipGetLastError(); }
    }
    if (ready < 0) return;
    Params p{};
    p.x = (const float*)d_in[0]; p.c = (const float*)d_in[1]; p.pos = (const int*)d_in[2]; p.w_ada = (const float*)d_in[3]; p.b_ada = (const float*)d_in[4]; p.w_in = (const float*)d_in[5];
    p.w_lr = (const float*)d_in[6]; p.b_lr = (const float*)d_in[7]; p.gnorm = (const float*)d_in[8]; p.sinks = (const float*)d_in[9]; p.w_o = (const float*)d_in[10]; p.ln1g = (const float*)d_in[11];
    p.ln1b = (const float*)d_in[12]; p.w_up = (const float*)d_in[13]; p.conv_w = (const float*)d_in[14]; p.conv_b = (const float*)d_in[15]; p.w_down = (const float*)d_in[16]; p.ln2g = (const float*)d_in[17];
    p.ln2b = (const float*)d_in[18]; p.out = (float*)d_out; p.ws = (unsigned char*)d_ws;
    if (hipMemsetAsync((unsigned char*)d_ws + OFF_BAR, 0, XCD_BAR_WORDS * 4, stream) != hipSuccess) { fprintf(stderr, "kernel_launch: memset of barrier words failed\n"); return; }
    void* args[] = {&p};
    hipError_t e = hipLaunchCooperativeKernel((const void*)mega, dim3(NWG), dim3(NTH), args, LDS_BYTES, stream);
    if (e != hipSuccess) fprintf(stderr, "kernel_launch: cooperative launch failed: %s\n", hipGetErrorString(e));
}
```
